# Optimizing an MI355X kernel written in HIP

```python
import math
import jax, jax.numpy as jnp
from jax import lax
import numpy as np

D_MODEL = 4096
BATCH = 2
SEQ = 4096
DEPTH = 2
DEC_BATCH = 4
DEC_SEQ = 4096
PAST_LEN = 128

GLA_HEADS = 4
GLA_DK = D_MODEL // 16
GLA_DV = D_MODEL // 8
GLA_QK = GLA_HEADS * GLA_DK
GLA_V = GLA_HEADS * GLA_DV
GLA_GATE_RANK = 16
GLA_GATE_NORMALIZER = 16.0
GLA_CHUNK = 64
HYENA_WIDTH = D_MODEL // 2
HYENA_SHORT_CONV = 3
HYENA_BANDS = 16
HYENA_EMB_DIM = 2 * HYENA_BANDS + 1
HYENA_FILTER_HIDDEN = 64
HYENA_SIN_FREQ = 1.0
HYENA_STRONG_DECAY_PCT = 0.3
HYENA_WEAK_DECAY_PCT = 1.5
HYENA_DECAY_TARGET = 1e-2
EVEN_SPLITS = (GLA_QK, GLA_QK, GLA_V, GLA_V, GLA_GATE_RANK, GLA_GATE_RANK, 3 * HYENA_WIDTH)
EVEN_IN = sum(EVEN_SPLITS)
EVEN_MIX = GLA_V + HYENA_WIDTH
SSD_INNER = D_MODEL // 2
SSD_HEADDIM = 64
SSD_HEADS = SSD_INNER // SSD_HEADDIM
SSD_GROUPS = 4
SSD_STATE = 128
SSD_BC = SSD_GROUPS * SSD_STATE
SSD_CONV = 4
SSD_CONV_DIM = SSD_INNER + 2 * SSD_BC
SSD_CHUNK = 128
LRU_WIDTH = D_MODEL // 2
LRU_BLOCKS = 16
LRU_BLOCK = LRU_WIDTH // LRU_BLOCKS
LRU_CONV = 4
LRU_C = 8.0
ODD_SPLITS = (SSD_INNER, SSD_CONV_DIM, 2 * SSD_HEADS, LRU_WIDTH, LRU_WIDTH)
ODD_IN = sum(ODD_SPLITS)
ODD_MIX = SSD_INNER + LRU_WIDTH
FFN_HIDDEN = 11008
FFN_CONV = 3
LN_EPS = 1e-5
RMS_EPS = 1e-6
DEEPNORM_ALPHA = (2.0 * DEPTH) ** 0.25
DEEPNORM_BETA = (8.0 * DEPTH) ** -0.25
N_EVEN = (DEPTH + 1) // 2
N_ODD = DEPTH // 2

kernel_name = "hybrid_bidir_gla_hyena_ssd_rglru_encoder"


def split_cols(t, sizes):
    idx = [int(v) for v in np.cumsum(sizes)[:-1]]
    return jnp.split(t, idx, axis=-1)


def flip_seq(t):
    return jnp.flip(t, axis=1)


def layer_norm(x, g, b):
    xf = x.astype(jnp.float32)
    mu = jnp.mean(xf, -1, keepdims=True)
    var = jnp.mean(jnp.square(xf - mu), -1, keepdims=True)
    return ((xf - mu) * lax.rsqrt(var + LN_EPS) * g + b).astype(x.dtype)


def rms_norm(x, g):
    xf = x.astype(jnp.float32)
    return xf * lax.rsqrt(jnp.mean(xf * xf, -1, keepdims=True) + RMS_EPS) * g.astype(jnp.float32)


def dwconv_centred(u, w, b):
    width = w.shape[0]
    left = (width - 1) // 2
    right = width - 1 - left
    L = u.shape[1]
    up = jnp.pad(u, ((0, 0), (left, right), (0, 0)))
    out = up[:, 0:L] * w[0]
    for j in range(1, width):
        out = out + up[:, j:j + L] * w[j]
    return out + b


def gla_chunked(q, k, v, log_a):
    Bsz, L, H, dk = q.shape
    dv = v.shape[-1]
    n = L // GLA_CHUNK
    def chunk(t):
        return t.reshape(Bsz, n, GLA_CHUNK, H, t.shape[-1])
    q, k, v, log_a = chunk(q), chunk(k), chunk(v), chunk(log_a)
    b = jnp.cumsum(log_a, axis=2)
    b_last = b[:, :, -1:]
    q_dec = q * jnp.exp(b)
    k_inv = k * jnp.exp(-b)
    mask = jnp.tril(jnp.ones((GLA_CHUNK, GLA_CHUNK), bool))
    scores = jnp.where(mask, jnp.einsum('bnchd,bnshd->bnhcs', q_dec, k_inv), 0.0)
    o_intra = jnp.einsum('bnhcs,bnshe->bnche', scores, v)
    kv = jnp.einsum('bnshd,bnshe->nbhde', k * jnp.exp(b_last - b), v)
    decay = jnp.exp(b_last[:, :, 0]).transpose(1, 0, 2, 3)
    def step(S, inp):
        dec, kv_n = inp
        return dec[..., None] * S + kv_n, S
    S0 = jnp.zeros((Bsz, H, dk, dv), jnp.float32)
    _, S_in = lax.scan(step, S0, (decay, kv))
    o_inter = jnp.einsum('bnchd,nbhde->bnche', q_dec, S_in)
    return (o_intra + o_inter).reshape(Bsz, L, H, dv)


def gla_mixer(q, k, v, og, lr_f, lr_b, wg_f, bg_f, wg_b, bg_b, norm_g):
    f32 = jnp.float32
    Bsz, L, _ = q.shape
    def heads(t, d):
        return t.astype(f32).reshape(Bsz, L, GLA_HEADS, d)
    qh = heads(q, GLA_DK) * (GLA_DK ** -0.5)
    kh = heads(k, GLA_DK)
    vh = heads(v, GLA_DV)
    la_f = heads(jax.nn.log_sigmoid(lr_f.astype(f32) @ wg_f.astype(f32) + bg_f.astype(f32)) / GLA_GATE_NORMALIZER, GLA_DK)
    la_b = heads(jax.nn.log_sigmoid(lr_b.astype(f32) @ wg_b.astype(f32) + bg_b.astype(f32)) / GLA_GATE_NORMALIZER, GLA_DK)
    o_f = gla_chunked(qh, kh, vh, la_f)
    o_b = flip_seq(gla_chunked(flip_seq(qh), flip_seq(kh), flip_seq(vh), flip_seq(la_b)))
    o = rms_norm(o_f + o_b, norm_g).reshape(Bsz, L, GLA_V)
    return o * jax.nn.silu(og.astype(f32))


def hyena_filters(L, w1, b1, w2, b2, w3):
    f32 = jnp.float32
    t = jnp.linspace(0.0, 1.0, L, dtype=f32)[:, None]
    bands = jnp.linspace(1e-4, HYENA_BANDS - 1, HYENA_BANDS, dtype=f32)
    w = 2.0 * math.pi * jnp.arange(L, dtype=f32)[:, None] / L
    z = jnp.concatenate([t, jnp.cos(bands * w), -jnp.sin(bands * w)], -1)
    h = jnp.sin(HYENA_SIN_FREQ * (z @ w1.astype(f32) + b1.astype(f32)))
    h = jnp.sin(HYENA_SIN_FREQ * (h @ w2.astype(f32) + b2.astype(f32)))
    h = h @ w3.astype(f32)
    max_decay = math.log(HYENA_DECAY_TARGET) / HYENA_STRONG_DECAY_PCT
    min_decay = math.log(HYENA_DECAY_TARGET) / HYENA_WEAK_DECAY_PCT
    deltas = jnp.linspace(min_decay, max_decay, HYENA_WIDTH, dtype=f32)
    window = jnp.exp(-t * jnp.abs(deltas))
    return h[:, :HYENA_WIDTH] * window, h[:, HYENA_WIDTH:] * window


def hyena_mixer(hy, conv_w, conv_b, w1, b1, w2, b2, w3, bias):
    f32 = jnp.float32
    L = hy.shape[1]
    uc = dwconv_centred(hy, conv_w, conv_b).astype(f32)
    x0, x1, v = split_cols(uc, (HYENA_WIDTH, HYENA_WIDTH, HYENA_WIDTH))
    h_f, h_b = hyena_filters(L, w1, b1, w2, b2, w3)
    k = jnp.concatenate([h_f, jnp.zeros((1, HYENA_WIDTH), f32), jnp.flip(h_b[1:], 0)], 0)
    k_f = jnp.fft.rfft(k, axis=0)
    u = v * x1
    u_f = jnp.fft.rfft(u, n=2 * L, axis=1)
    y = jnp.fft.irfft(u_f * k_f, n=2 * L, axis=1)[:, :L] + u * bias.astype(f32)
    return y * x0


def ssd_chunked(x, dt, A, bm, cm):
    Bsz, L, G, Hg, P = x.shape
    N = bm.shape[-1]
    n = L // SSD_CHUNK
    Q = SSD_CHUNK
    x = x.reshape(Bsz, n, Q, G, Hg, P)
    dt = dt.reshape(Bsz, n, Q, G, Hg)
    bm = bm.reshape(Bsz, n, Q, G, N)
    cm = cm.reshape(Bsz, n, Q, G, N)
    xdt = x * dt[..., None]
    ac = jnp.cumsum((dt * A).transpose(0, 1, 3, 4, 2), axis=-1)
    seg = ac[..., :, None] - ac[..., None, :]
    mask = jnp.tril(jnp.ones((Q, Q), bool))
    lmat = jnp.exp(jnp.where(mask, seg, -jnp.inf))
    cb = jnp.einsum('bnlgd,bnsgd->bngls', cm, bm)
    y_diag = jnp.einsum('bngls,bnghls,bnsghp->bnlghp', cb, lmat, xdt)
    decay_states = jnp.exp(ac[..., -1:] - ac)
    states = jnp.einsum('bnsgd,bnghs,bnsghp->nbghpd', bm, decay_states, xdt)
    chunk_decay = jnp.exp(ac[..., -1]).transpose(1, 0, 2, 3)
    def step(S, inp):
        dec, st = inp
        return dec[..., None, None] * S + st, S
    S0 = jnp.zeros((Bsz, G, Hg, P, N), jnp.float32)
    _, S_in = lax.scan(step, S0, (chunk_decay, states))
    y_off = jnp.einsum('bnlgd,bnghl,nbghpd->bnlghp', cm, jnp.exp(ac), S_in)
    return (y_diag + y_off).reshape(Bsz, L, G, Hg, P)


def ssd_mixer(z, xbc, dt_raw, conv_w, conv_b, dt_bias, a_log, d_skip, norm_g):
    f32 = jnp.float32
    Bsz, L, _ = z.shape
    G, Hg = SSD_GROUPS, SSD_HEADS // SSD_GROUPS
    xbc = jax.nn.silu(dwconv_centred(xbc, conv_w, conv_b).astype(f32))
    xs, bm, cm = split_cols(xbc, (SSD_INNER, SSD_BC, SSD_BC))
    xs = xs.reshape(Bsz, L, G, Hg, SSD_HEADDIM)
    bm = bm.reshape(Bsz, L, G, SSD_STATE)
    cm = cm.reshape(Bsz, L, G, SSD_STATE)
    dt = jax.nn.softplus(dt_raw.astype(f32).reshape(Bsz, L, 2, G, Hg) + dt_bias.astype(f32).reshape(2, G, Hg))
    A = -jnp.exp(a_log.astype(f32)).reshape(2, G, Hg)
    dsk = d_skip.astype(f32).reshape(2, G, Hg, 1)
    y_f = ssd_chunked(xs, dt[:, :, 0], A[0], bm, cm)
    y_b = flip_seq(ssd_chunked(flip_seq(xs), flip_seq(dt[:, :, 1]), A[1], flip_seq(bm), flip_seq(cm)))
    y = (y_f + y_b + xs * (dsk[0] + dsk[1])).reshape(Bsz, L, SSD_INNER)
    y = y * jax.nn.silu(z.astype(f32))
    y = rms_norm(y.reshape(Bsz, L, G, SSD_INNER // G), norm_g.reshape(G, SSD_INNER // G))
    return y.reshape(Bsz, L, SSD_INNER)


def rglru_dir(xc, wa, ba, wx, bx, lam):
    f32 = jnp.float32
    Bsz, L, W = xc.shape
    xb = xc.reshape(Bsz, L, LRU_BLOCKS, LRU_BLOCK)
    r = jax.nn.sigmoid(jnp.einsum('blkc,kcd->blkd', xb, wa.astype(f32)).reshape(Bsz, L, W) + ba.astype(f32))
    i = jax.nn.sigmoid(jnp.einsum('blkc,kcd->blkd', xb, wx.astype(f32)).reshape(Bsz, L, W) + bx.astype(f32))
    log_a = -LRU_C * r * jax.nn.softplus(-lam.astype(f32))
    a = jnp.exp(log_a)
    b = jnp.sqrt(-jnp.expm1(2.0 * log_a)) * (i * xc)
    def combine(e1, e2):
        a1, b1 = e1
        a2, b2 = e2
        return a1 * a2, a2 * b1 + b2
    _, h = lax.associative_scan(combine, (a, b), axis=1)
    return h


def lru_mixer(gate_in, x_in, conv_w, conv_b, wa, ba, wx, bx, lam):
    f32 = jnp.float32
    xc = dwconv_centred(x_in, conv_w, conv_b).astype(f32)
    h_f = rglru_dir(xc, wa[0], ba[0], wx[0], bx[0], lam[0])
    h_b = flip_seq(rglru_dir(flip_seq(xc), wa[1], ba[1], wx[1], bx[1], lam[1]))
    return jax.nn.gelu(gate_in.astype(f32)) * (h_f + h_b)


def conv_ffn(x, w_up, conv_w, conv_b, w_down):
    h = dwconv_centred(x @ w_up, conv_w, conv_b)
    g, u = split_cols(h, (FFN_HIDDEN, FFN_HIDDEN))
    return (jax.nn.silu(g) * u) @ w_down


def setup_inputs(seed: int = 0) -> dict:
    key = jax.random.key(seed)
    ks = iter(jax.random.split(key, 64))
    f32 = jnp.float32
    def nrm(shape, scale):
        return jax.random.normal(next(ks), shape, f32) * scale
    def gain(shape):
        return 1.0 + nrm(shape, 0.02)
    def small(shape):
        return nrm(shape, 0.02)
    E, O, HW = N_EVEN, N_ODD, HYENA_WIDTH
    dt0 = jnp.exp(jax.random.uniform(next(ks), (O, 2, SSD_HEADS), f32, math.log(1e-3), math.log(1e-1)))
    dt_bias = dt0 + jnp.log(-jnp.expm1(-dt0))
    a_log = jnp.log(jax.random.uniform(next(ks), (O, 2, SSD_HEADS), f32, 1.0, 16.0))
    a_c = jax.random.uniform(next(ks), (O, 2, LRU_WIDTH), f32, 0.9, 0.999)
    a_base = a_c ** (1.0 / LRU_C)
    lam = jnp.log(a_base) - jnp.log1p(-a_base)
    return {
        "x_prompt": nrm((BATCH, SEQ, D_MODEL), 1.0),
        "x_sample": nrm((DEC_BATCH, DEC_SEQ, D_MODEL), 1.0),
        "ev_w_in": nrm((E, D_MODEL, EVEN_IN), D_MODEL ** -0.5),
        "ev_gla_wg_f": nrm((E, GLA_GATE_RANK, GLA_QK), GLA_GATE_RANK ** -0.5),
        "ev_gla_bg_f": nrm((E, GLA_QK), 0.1),
        "ev_gla_wg_b": nrm((E, GLA_GATE_RANK, GLA_QK), GLA_GATE_RANK ** -0.5),
        "ev_gla_bg_b": nrm((E, GLA_QK), 0.1),
        "ev_gla_norm": gain((E, GLA_DV)),
        "ev_hy_conv_w": nrm((E, HYENA_SHORT_CONV, 3 * HW), HYENA_SHORT_CONV ** -0.5),
        "ev_hy_conv_b": small((E, 3 * HW)),
        "ev_hy_w1": nrm((E, HYENA_EMB_DIM, HYENA_FILTER_HIDDEN), HYENA_EMB_DIM ** -0.5),
        "ev_hy_b1": nrm((E, HYENA_FILTER_HIDDEN), 0.1),
        "ev_hy_w2": nrm((E, HYENA_FILTER_HIDDEN, HYENA_FILTER_HIDDEN), HYENA_FILTER_HIDDEN ** -0.5),
        "ev_hy_b2": nrm((E, HYENA_FILTER_HIDDEN), 0.1),
        "ev_hy_w3": nrm((E, HYENA_FILTER_HIDDEN, 2 * HW), 0.05 * HYENA_FILTER_HIDDEN ** -0.5),
        "ev_hy_bias": nrm((E, HW), 1.0),
        "ev_w_out": nrm((E, EVEN_MIX, D_MODEL), DEEPNORM_BETA * EVEN_MIX ** -0.5),
        "od_w_in": nrm((O, D_MODEL, ODD_IN), D_MODEL ** -0.5),
        "od_ssd_conv_w": nrm((O, SSD_CONV, SSD_CONV_DIM), SSD_CONV ** -0.5),
        "od_ssd_conv_b": small((O, SSD_CONV_DIM)),
        "od_ssd_dt_bias": dt_bias,
        "od_ssd_a_log": a_log,
        "od_ssd_d": gain((O, 2, SSD_HEADS)),
        "od_ssd_norm": gain((O, SSD_INNER)),
        "od_lru_conv_w": nrm((O, LRU_CONV, LRU_WIDTH), LRU_CONV ** -0.5),
        "od_lru_conv_b": small((O, LRU_WIDTH)),
        "od_lru_wa": nrm((O, 2, LRU_BLOCKS, LRU_BLOCK, LRU_BLOCK), LRU_BLOCK ** -0.5),
        "od_lru_ba": small((O, 2, LRU_WIDTH)),
        "od_lru_wx": nrm((O, 2, LRU_BLOCKS, LRU_BLOCK, LRU_BLOCK), LRU_BLOCK ** -0.5),
        "od_lru_bx": small((O, 2, LRU_WIDTH)),
        "od_lru_lambda": lam,
        "od_w_out": nrm((O, ODD_MIX, D_MODEL), DEEPNORM_BETA * ODD_MIX ** -0.5),
        "ln1_g": gain((DEPTH, D_MODEL)),
        "ln1_b": small((DEPTH, D_MODEL)),
        "ffn_w_up": nrm((DEPTH, D_MODEL, 2 * FFN_HIDDEN), D_MODEL ** -0.5),
        "ffn_conv_w": nrm((DEPTH, FFN_CONV, 2 * FFN_HIDDEN), FFN_CONV ** -0.5),
        "ffn_conv_b": small((DEPTH, 2 * FFN_HIDDEN)),
        "ffn_w_down": nrm((DEPTH, FFN_HIDDEN, D_MODEL), DEEPNORM_BETA * FFN_HIDDEN ** -0.5),
        "ln2_g": gain((DEPTH, D_MODEL)),
        "ln2_b": small((DEPTH, D_MODEL)),
    }


def reference(x_prompt, x_sample,
              ev_w_in, ev_gla_wg_f, ev_gla_bg_f, ev_gla_wg_b, ev_gla_bg_b, ev_gla_norm,
              ev_hy_conv_w, ev_hy_conv_b, ev_hy_w1, ev_hy_b1, ev_hy_w2, ev_hy_b2, ev_hy_w3, ev_hy_bias,
              ev_w_out,
              od_w_in, od_ssd_conv_w, od_ssd_conv_b, od_ssd_dt_bias, od_ssd_a_log, od_ssd_d, od_ssd_norm,
              od_lru_conv_w, od_lru_conv_b, od_lru_wa, od_lru_ba, od_lru_wx, od_lru_bx, od_lru_lambda,
              od_w_out,
              ln1_g, ln1_b, ffn_w_up, ffn_conv_w, ffn_conv_b, ffn_w_down, ln2_g, ln2_b):

    def even_mixer(x, j):
        proj = x @ ev_w_in[j]
        q, k, v, og, lr_f, lr_b, hy = split_cols(proj, EVEN_SPLITS)
        a = gla_mixer(q, k, v, og, lr_f, lr_b, ev_gla_wg_f[j], ev_gla_bg_f[j],
                      ev_gla_wg_b[j], ev_gla_bg_b[j], ev_gla_norm[j])
        h = hyena_mixer(hy, ev_hy_conv_w[j], ev_hy_conv_b[j], ev_hy_w1[j], ev_hy_b1[j],
                        ev_hy_w2[j], ev_hy_b2[j], ev_hy_w3[j], ev_hy_bias[j])
        return jnp.concatenate([a, h], -1).astype(x.dtype) @ ev_w_out[j]

    def odd_mixer(x, j):
        proj = x @ od_w_in[j]
        z, xbc, dt_raw, g_in, r_in = split_cols(proj, ODD_SPLITS)
        s = ssd_mixer(z, xbc, dt_raw, od_ssd_conv_w[j], od_ssd_conv_b[j], od_ssd_dt_bias[j],
                      od_ssd_a_log[j], od_ssd_d[j], od_ssd_norm[j])
        r = lru_mixer(g_in, r_in, od_lru_conv_w[j], od_lru_conv_b[j], od_lru_wa[j], od_lru_ba[j],
                      od_lru_wx[j], od_lru_bx[j], od_lru_lambda[j])
        return jnp.concatenate([s, r], -1).astype(x.dtype) @ od_w_out[j]

    def run(x):
        for i in range(DEPTH):
            j = i // 2
            mix = even_mixer(x, j) if i % 2 == 0 else odd_mixer(x, j)
            x = layer_norm(DEEPNORM_ALPHA * x + mix, ln1_g[i], ln1_b[i])
            ffn = conv_ffn(x, ffn_w_up[i], ffn_conv_w[i], ffn_conv_b[i], ffn_w_down[i])
            x = layer_norm(DEEPNORM_ALPHA * x + ffn, ln2_g[i], ln2_b[i])
        return x

    y_prompt = run(x_prompt)
    y_sample = run(x_sample)
    return (y_prompt, y_sample)
```

```cpp
#ifndef HOST_EMU
#include <hip/hip_runtime.h>
#endif
#include <cstdio>
#include <cstdint>

#ifndef SMALL_CFG
constexpr int DM = 4096, SEQ = 4096, NSEQ_P = 2, NSEQ_S = 4;
constexpr int GH = 4;
constexpr int HW = 2048;
constexpr int SG = 4, SHG = 8;
constexpr int LNB = 16;
constexpr int FF = 11008;
constexpr int NLAYER = 2;
#else
#ifndef CFG_SEQ
#define CFG_SEQ 256
#endif
#ifndef CFG_GH
#define CFG_GH 1
#endif
#ifndef CFG_NP
#define CFG_NP 1
#endif
#ifndef CFG_NS
#define CFG_NS 1
#endif
constexpr int DM = 256, SEQ = CFG_SEQ, NSEQ_P = CFG_NP, NSEQ_S = CFG_NS;
constexpr int GH = CFG_GH;
constexpr int HW = 128;
constexpr int SG = 2, SHG = 8;
constexpr int LNB = 2;
constexpr int FF = 256;
constexpr int NLAYER = 2;
#endif
constexpr int NSEQ = NSEQ_P + NSEQ_S, T = NSEQ * SEQ;
constexpr int GDK = 256, GDV = 512, GQK = GH * GDK, GV = GH * GDV, GR = 16, GCH = 64;
constexpr int HEMB = 33, HFH = 64, HBANDS = 16;
constexpr int EIN = 2 * GQK + 2 * GV + 2 * GR + 3 * HW;
constexpr int EIN_P = (EIN + 255) / 256 * 256;
constexpr int EMIX = GV + HW;
constexpr int E_Q = 0, E_K = GQK, E_V = 2 * GQK, E_OG = 2 * GQK + GV, E_LRF = 2 * GQK + 2 * GV, E_LRB = E_LRF + GR, E_HY = E_LRB + GR;
constexpr int SNH = SG * SHG, SP = 64, SN = 128, SIN = SNH * SP, SBC = SG * SN, SCD = SIN + 2 * SBC;
constexpr int LW = LNB * 128;
constexpr int OIN = SIN + SCD + 2 * SNH + 2 * LW;
constexpr int OIN_P = (OIN + 255) / 256 * 256;
constexpr int OMIX = SIN + LW;
constexpr int O_Z = 0, O_XBC = SIN, O_DT = SIN + SCD, O_G = O_DT + 2 * SNH, O_R = O_G + LW;
constexpr int FF2 = 2 * FF;
constexpr float LN_EPS = 1e-5f, RMS_EPS = 1e-6f;
constexpr float DN_ALPHA = 1.4142135623730951f;
static_assert(EIN % 32 == 0 && OIN % 32 == 0 && FF2 % 32 == 0 && DM % 64 == 0 && FF % 64 == 0 && EMIX % 64 == 0 && OMIX % 64 == 0, "prologue transposition items");
static_assert(T % 256 == 0 && FF2 % 256 == 0 && DM % 256 == 0 && (NSEQ_P * SEQ) % 256 == 0, "GEMM tiles");

#ifndef HOST_EMU
#define GAS __attribute__((address_space(1)))
#define LAS __attribute__((address_space(3)))
#else
#define GAS
#define LAS
#endif
typedef unsigned short bf16;
typedef unsigned v4u __attribute__((ext_vector_type(4)));
typedef unsigned v2u __attribute__((ext_vector_type(2)));
typedef float v4f __attribute__((ext_vector_type(4)));
typedef float v2f __attribute__((ext_vector_type(2)));
typedef short v8s __attribute__((ext_vector_type(8)));
#define DI __device__ __forceinline__
#ifndef HOST_EMU
DI unsigned pk2(float lo, float hi) { unsigned r; asm("v_cvt_pk_bf16_f32 %0, %1, %2" : "=v"(r) : "v"(lo), "v"(hi)); return r; }
DI unsigned f2bf(float f) { return pk2(f, 0.f) & 0xffffu; }
DI float frcp(float x) { return __builtin_amdgcn_rcpf(x); }
DI float frsq(float x) { return __builtin_amdgcn_rsqf(x); }
DI float fsqrt_(float x) { return __builtin_amdgcn_sqrtf(x); }
#else
DI unsigned f2bf(float f) { unsigned u = __builtin_bit_cast(unsigned, f); return (u + 0x7fffu + ((u >> 16) & 1u)) >> 16; }
DI unsigned pk2(float lo, float hi) { return f2bf(lo) | (f2bf(hi) << 16); }
DI float frcp(float x) { return 1.f / x; }
DI float frsq(float x) { return 1.f / sqrtf(x); }
DI float fsqrt_(float x) { return sqrtf(x); }
#endif
DI float bf2f(unsigned b) { return __builtin_bit_cast(float, b << 16); }
DI float bflo(unsigned w) { return __builtin_bit_cast(float, w << 16); }
DI float bfhi(unsigned w) { return __builtin_bit_cast(float, w & 0xffff0000u); }
DI float sigmoidf_(float x) { return frcp(1.f + __expf(-x)); }
DI float siluf_(float x) { return x * frcp(1.f + __expf(-x)); }
DI float softplusf_(float x) { return (x > 0.f ? x : 0.f) + log1pf(__expf(-fabsf(x))); }
#ifndef HOST_EMU
#define WAVE_SYNC() asm volatile("s_waitcnt lgkmcnt(0)" ::: "memory")
#define LDS_WAIT() asm volatile("s_waitcnt lgkmcnt(0)" ::: "memory")
#define VM_WAIT() asm volatile("s_waitcnt vmcnt(0)" ::: "memory")
#define CFENCE() asm volatile("" ::: "memory")
#else
#define CFENCE() do {} while (0)
#endif

#ifndef HOST_EMU
#define DECL_DYN_LDS(name) extern __shared__ __attribute__((aligned(16))) unsigned char name[]
#endif
namespace pg8 {
#ifndef HOST_EMU
#define PG8_LAS __attribute__((address_space(3)))
#else
#define PG8_LAS
#endif
typedef unsigned short bf16_t;
typedef short bf16x8 __attribute__((ext_vector_type(8)));
typedef float f32x4 __attribute__((ext_vector_type(4)));
typedef unsigned u32x4 __attribute__((ext_vector_type(4)));
constexpr int BM = 256, BK = 64, HALF = 128, HTB = HALF * BK * 2  , STAGE_BYTES = 8 * HTB, NXCD = 8, WGM = 4;

__host__ __device__ __forceinline__ int lds_byte(int r, int c) { const int st = (r >> 4) * 2 + (c >> 5), rr = r & 15, cc = c & 31, ob = rr * 64 + cc * 2; return st * 1024 + (ob ^ (((ob >> 9) & 1) << 5)); }
__host__ __device__ __forceinline__ void stage_rc(int b, int& R, int& C) { const int st = b / 1024, sb = b % 1024, swz = sb ^ (((sb >> 9) & 1) << 5); R = (st >> 1) * 16 + swz / 64; C = (st & 1) * 32 + (swz % 64) / 2; }
__host__ __device__ __forceinline__ int perm32(int rho) { const int n = rho >> 4, i = rho & 15; return 8 * (i >> 2) + 4 * n + (i & 3); }

struct Unit { int pm, pn; };
struct Gemm { const bf16_t* A; const bf16_t* Bt; int M, N, K; };

struct StaticOrder {
    int nM, nN, nwg, G, c;
    __host__ __device__ void init(int M, int N, int G_, int c_) { nM = M / BM; nN = N / BM; nwg = nM * nN; G = G_; c = c_; }
    __host__ __device__ bool next(int i, Unit& u) const {
        const long L = (long)i * G + c; if (L >= nwg) return false;
        int wgid = (int)L; { const int q = nwg / NXCD, r = nwg % NXCD, xcd = wgid % NXCD, off = wgid / NXCD; wgid = (xcd < r ? xcd * (q + 1) : r * (q + 1) + (xcd - r) * q) + off; }
        const int nig = WGM * nN, gid = wgid / nig, fm = gid * WGM, gsz = (nM - fm) < WGM ? (nM - fm) : WGM;
        u.pm = fm + ((wgid % nig) % gsz); u.pn = (wgid % nig) / gsz; return true;
    }
    __device__ __forceinline__ void a_ready(const Unit&) const {}
    __device__ __forceinline__ void done(const Unit&) const {}
};

#ifndef HOST_EMU
__device__ __forceinline__ unsigned cvt_pk_bf16(float lo, float hi) { unsigned r; asm volatile("v_cvt_pk_bf16_f32 %0, %1, %2" : "=v"(r) : "v"(lo), "v"(hi)); return r; }
#else
__device__ __forceinline__ unsigned cvt_pk_bf16(float lo, float hi) { return pk2(lo, hi); }
#endif
typedef float f32x2 __attribute__((ext_vector_type(2)));
__device__ __forceinline__ f32x2 gelu_pk(f32x2 v) {
    const f32x2 av = __builtin_elementwise_abs(v), d = av * 0.2316418882f + 1.0f;
#ifndef HOST_EMU
    f32x2 t; t.x = __builtin_amdgcn_rcpf(d.x); t.y = __builtin_amdgcn_rcpf(d.y);
#else
    f32x2 t; t.x = 1.f / d.x; t.y = 1.f / d.y;
#endif
    f32x2 q = t * 0.5307027145f + (-0.7265760135f); q = q * t + 0.7107068705f; q = q * t + (-0.142248368f); q = q * t + 0.127414796f; q = q * t;
    const f32x2 s = (v * v) * (-0.72134752044f);
#ifndef HOST_EMU
    f32x2 e; e.x = __builtin_amdgcn_exp2f(s.x); e.y = __builtin_amdgcn_exp2f(s.y);
#else
    f32x2 e; e.x = exp2f(s.x); e.y = exp2f(s.y);
#endif
    const f32x2 m = v * (q * e), r = v - m;
    f32x2 o; o.x = v.x < 0.f ? m.x : r.x; o.y = v.y < 0.f ? m.y : r.y; return o;
}

template <int ACT  > struct EpiBf16 {
    static constexpr bool PERM = true, AFTER_DRAIN = false; static_assert(ACT == 0 || ACT == 1, "EpiBf16: ACT is 0 (none) or 1 (gelu_pk)");
    bf16_t* O; int ldc; const float* bias; int split_cols; size_t split_stride; float scale0;
    __device__ __forceinline__ void operator()(const f32x4 (&acc)[2][2][4][2], const Unit& u, int wr, int wc, int fr, int fq) const {
        const int row0 = u.pm * BM + wr * 64 + fr; int colt = u.pn * BM; bf16_t* base = O;
        float sc = 1.f; if (split_cols) { const int t = colt / split_cols; base += (size_t)t * split_stride; colt -= t * split_cols; if (t == 0) sc = scale0; }
        const int col0 = colt + wc * 32 + 8 * fq, bcol0 = u.pn * BM + wc * 32 + 8 * fq;
        f32x4 bv[2][2];
#pragma unroll
        for (int bj = 0; bj < 2; ++bj)
#pragma unroll
            for (int n = 0; n < 2; ++n) bv[bj][n] = bias ? *(const f32x4*)(bias + bcol0 + bj * HALF + 4 * n) : (f32x4){0.f, 0.f, 0.f, 0.f};
#pragma unroll
        for (int ai = 0; ai < 2; ++ai)
#pragma unroll
            for (int m = 0; m < 4; ++m) { bf16_t* rowp = base + (size_t)(row0 + ai * HALF + m * 16) * ldc + col0;
#pragma unroll
                for (int bj = 0; bj < 2; ++bj) { f32x4 v0 = acc[ai][bj][m][0] + bv[bj][0], v1 = acc[ai][bj][m][1] + bv[bj][1];
                    if (ACT == 1) { f32x2 a = gelu_pk((f32x2){v0[0], v0[1]}), b = gelu_pk((f32x2){v0[2], v0[3]}), c = gelu_pk((f32x2){v1[0], v1[1]}), d = gelu_pk((f32x2){v1[2], v1[3]});
                        v0 = (f32x4){a.x, a.y, b.x, b.y}; v1 = (f32x4){c.x, c.y, d.x, d.y}; }
                    v0 = v0 * sc; v1 = v1 * sc; u32x4 w; w.x = cvt_pk_bf16(v0[0], v0[1]); w.y = cvt_pk_bf16(v0[2], v0[3]); w.z = cvt_pk_bf16(v1[0], v1[1]); w.w = cvt_pk_bf16(v1[2], v1[3]);
                    *(u32x4*)(rowp + bj * HALF) = w; } }
    }
};
struct EpiResF32 {
    static constexpr bool PERM = false, AFTER_DRAIN = false;
    const float* res; float* out; int ldc; float alpha;
    const float* stats; const float* lg; const float* lb;
    const float* res2; int split;
    __device__ __forceinline__ void operator()(const f32x4 (&acc)[2][2][4][2], const Unit& u, int wr, int wc, int fr, int fq) const {
        const int row0 = u.pm * BM + wr * 64 + fr, col0 = u.pn * BM + wc * 32 + 4 * fq;
        const float* rbase = (res2 && u.pm * BM >= split) ? res2 - (size_t)split * ldc : res;
        f32x4 gv[2][2], bv[2][2];
        if (stats) {
#pragma unroll
            for (int bj = 0; bj < 2; ++bj)
#pragma unroll
                for (int n = 0; n < 2; ++n) { gv[bj][n] = *(const f32x4*)(lg + col0 + bj * HALF + n * 16); bv[bj][n] = *(const f32x4*)(lb + col0 + bj * HALF + n * 16); } }
#pragma unroll
        for (int ai = 0; ai < 2; ++ai)
#pragma unroll
            for (int m = 0; m < 4; ++m) { const int row = row0 + ai * HALF + m * 16; const size_t off = (size_t)row * ldc + col0;
                f32x4 rv[2][2];
#pragma unroll
                for (int bj = 0; bj < 2; ++bj)
#pragma unroll
                    for (int n = 0; n < 2; ++n) rv[bj][n] = *(const f32x4*)(rbase + off + bj * HALF + n * 16);
                if (stats) { const float mu = stats[2 * row], rs = stats[2 * row + 1];
#pragma unroll
                    for (int bj = 0; bj < 2; ++bj)
#pragma unroll
                        for (int n = 0; n < 2; ++n) rv[bj][n] = (rv[bj][n] - mu) * rs * gv[bj][n] + bv[bj][n]; }
#pragma unroll
                for (int bj = 0; bj < 2; ++bj)
#pragma unroll
                    for (int n = 0; n < 2; ++n) *(f32x4*)(out + off + bj * HALF + n * 16) = rv[bj][n] * alpha + acc[ai][bj][m][n]; }
    }
};

template <bool RES_F32> struct EpiResBf {
    static constexpr bool PERM = true, AFTER_DRAIN = false;
    const void* res; const float* res2; int split;
    bf16_t* out; int ldc; float alpha;
    const float* stats; const float* lg; const float* lb;
    __device__ __forceinline__ void operator()(const f32x4 (&acc)[2][2][4][2], const Unit& u, int wr, int wc, int fr, int fq) const {
        const int row0 = u.pm * BM + wr * 64 + fr, col8 = u.pn * BM + wc * 32 + 8 * fq;
        f32x4 gv[2][2], bv[2][2];
        if (stats) {
#pragma unroll
            for (int bj = 0; bj < 2; ++bj)
#pragma unroll
                for (int n = 0; n < 2; ++n) { gv[bj][n] = *(const f32x4*)(lg + col8 + bj * HALF + 4 * n); bv[bj][n] = *(const f32x4*)(lb + col8 + bj * HALF + 4 * n); } }
#pragma unroll
        for (int ai = 0; ai < 2; ++ai)
#pragma unroll
            for (int m = 0; m < 4; ++m) { const int row = row0 + ai * HALF + m * 16; const size_t off = (size_t)row * ldc + col8;
                f32x4 rv[2][2];
                if constexpr (RES_F32) { const float* rb_ = (res2 && u.pm * BM >= split) ? res2 - (size_t)split * ldc : (const float*)res;
#pragma unroll
                    for (int bj = 0; bj < 2; ++bj)
#pragma unroll
                        for (int n = 0; n < 2; ++n) rv[bj][n] = *(const f32x4*)(rb_ + off + bj * HALF + 4 * n);
                } else {
#pragma unroll
                    for (int bj = 0; bj < 2; ++bj) { const u32x4 w = *(const u32x4*)((const bf16_t*)res + off + bj * HALF);
                        rv[bj][0] = (f32x4){bflo(w.x), bfhi(w.x), bflo(w.y), bfhi(w.y)}; rv[bj][1] = (f32x4){bflo(w.z), bfhi(w.z), bflo(w.w), bfhi(w.w)}; } }
                if (stats) { const float mu = stats[2 * row], rs = stats[2 * row + 1];
#pragma unroll
                    for (int bj = 0; bj < 2; ++bj)
#pragma unroll
                        for (int n = 0; n < 2; ++n) rv[bj][n] = (rv[bj][n] - mu) * rs * gv[bj][n] + bv[bj][n]; }
#pragma unroll
                for (int bj = 0; bj < 2; ++bj) { const f32x4 y0 = rv[bj][0] * alpha + acc[ai][bj][m][0], y1 = rv[bj][1] * alpha + acc[ai][bj][m][1];
                    u32x4 w; w.x = cvt_pk_bf16(y0[0], y0[1]); w.y = cvt_pk_bf16(y0[2], y0[3]); w.z = cvt_pk_bf16(y1[0], y1[1]); w.w = cvt_pk_bf16(y1[2], y1[3]);
                    *(u32x4*)(out + off + bj * HALF) = w; } }
    }
};

#ifndef HOST_EMU
__device__ __forceinline__ float rot_r16(float x) { return __builtin_bit_cast(float, __builtin_amdgcn_update_dpp(0, __builtin_bit_cast(int, x), 0x121, 0xf, 0xf, false)); }
__device__ __forceinline__ float rot_l16(float x) { return __builtin_bit_cast(float, __builtin_amdgcn_update_dpp(0, __builtin_bit_cast(int, x), 0x12F, 0xf, 0xf, false)); }
#else
__device__ __forceinline__ float rot_r16(float x) { const int l = threadIdx.x & 63; return __shfl(x, (l & ~15) | ((l - 1) & 15)); }
__device__ __forceinline__ float rot_l16(float x) { const int l = threadIdx.x & 63; return __shfl(x, (l & ~15) | ((l + 1) & 15)); }
#endif
struct EpiConvGate {
    static constexpr bool PERM = true, AFTER_DRAIN = false;
    bf16_t* ACT; int ff;
    const float* cw; const float* cb;
    float* edgeg;
    PG8_LAS float* edge;
    __device__ __forceinline__ void operator()(const f32x4 (&acc)[2][2][4][2], const Unit& u, int wr, int wc, int fr, int fq) const {
        const int lc = wc * 32 + 8 * fq;
        const int ch0 = u.pn * HALF + lc;
        const int nN = 2 * ff / BM;
#pragma unroll
        for (int ai = 0; ai < 2; ++ai) { const int bi = 2 * ai + wr;
#pragma unroll
            for (int bj = 0; bj < 2; ++bj)
#pragma unroll
                for (int n = 0; n < 2; ++n) {
                    if (fr == 0) *(PG8_LAS f32x4*)(edge + (bi * 2 + 0) * BM + bj * HALF + lc + 4 * n) = acc[ai][bj][0][n];
                    if (fr == 15) *(PG8_LAS f32x4*)(edge + (bi * 2 + 1) * BM + bj * HALF + lc + 4 * n) = acc[ai][bj][3][n];
                    if (bi == 0 && fr < 2) *(f32x4*)(edgeg + (((size_t)u.pm * 4 + fr) * nN + u.pn) * BM + bj * HALF + lc + 4 * n) = acc[ai][bj][0][n];
                    if (bi == 3 && fr >= 14) *(f32x4*)(edgeg + (((size_t)u.pm * 4 + (fr - 12)) * nN + u.pn) * BM + bj * HALF + lc + 4 * n) = acc[ai][bj][3][n];
                } }
#ifndef HOST_EMU
        asm volatile("s_waitcnt lgkmcnt(0)" ::: "memory"); __builtin_amdgcn_s_barrier(); asm volatile("" ::: "memory");
#else
        __syncthreads();
#endif
        typedef unsigned u32x2_ __attribute__((ext_vector_type(2)));
        u32x2_ keep[2][4];
#pragma unroll
        for (int n = 0; n < 2; ++n) {
            f32x4 wg[3], wu[3], bg, bu;
#pragma unroll
            for (int j = 0; j < 3; ++j) { wg[j] = *(const f32x4*)(cw + (size_t)j * 2 * ff + ch0 + 4 * n); wu[j] = *(const f32x4*)(cw + (size_t)j * 2 * ff + ff + ch0 + 4 * n); }
            bg = *(const f32x4*)(cb + ch0 + 4 * n); bu = *(const f32x4*)(cb + ff + ch0 + 4 * n);
#pragma unroll
            for (int ai = 0; ai < 2; ++ai) { const int bi = 2 * ai + wr;
#pragma unroll
                for (int m = 0; m < 4; ++m) {
                    f32x4 cv[2];
#pragma unroll
                    for (int bj = 0; bj < 2; ++bj) {
                        const f32x4 x = acc[ai][bj][m][n]; f32x4 up, dn, pu, nd;
#pragma unroll
                        for (int i = 0; i < 4; ++i) { up[i] = rot_r16(x[i]); dn[i] = rot_l16(x[i]); }
                        if (m > 0) {
#pragma unroll
                            for (int i = 0; i < 4; ++i) pu[i] = rot_r16(acc[ai][bj][m > 0 ? m - 1 : 0][n][i]);
                        } else pu = (bi > 0) ? *(const PG8_LAS f32x4*)(edge + ((bi - 1) * 2 + 1) * BM + bj * HALF + lc + 4 * n) : (f32x4){0.f, 0.f, 0.f, 0.f};
                        if (m < 3) {
#pragma unroll
                            for (int i = 0; i < 4; ++i) nd[i] = rot_l16(acc[ai][bj][m < 3 ? m + 1 : 3][n][i]);
                        } else nd = (bi < 3) ? *(const PG8_LAS f32x4*)(edge + ((bi + 1) * 2 + 0) * BM + bj * HALF + lc + 4 * n) : (f32x4){0.f, 0.f, 0.f, 0.f};
                        if (fr == 0) up = pu;
                        if (fr == 15) dn = nd;
                        cv[bj] = bj ? (up * wu[0] + x * wu[1] + dn * wu[2] + bu) : (up * wg[0] + x * wg[1] + dn * wg[2] + bg);
                    }
                    f32x4 a;
#pragma unroll
                    for (int i = 0; i < 4; ++i) a[i] = cv[0][i] * frcp(1.0f + __expf(-cv[0][i])) * cv[1][i];
                    const u32x2_ pk = {cvt_pk_bf16(a[0], a[1]), cvt_pk_bf16(a[2], a[3])};
                    if (n == 0) keep[ai][m] = pk;
                    else { const u32x4 o = {keep[ai][m].x, keep[ai][m].y, pk.x, pk.y};
                        *(u32x4*)(ACT + (size_t)(u.pm * BM + ai * HALF + wr * 64 + m * 16 + fr) * ff + ch0) = o; }
                } }
#ifndef HOST_EMU
            asm volatile("" ::: "memory");
#endif
        }
    }
};
#ifndef HOST_EMU
template <class Epi, class Sched, bool ALIGN_EPI = false, bool SP2 = false>
__device__ __forceinline__ void gemm_phase(PG8_LAS unsigned char* lds, const Gemm g, const Sched& S, const Epi& E) {
    const int tid = threadIdx.x, wid = __builtin_amdgcn_readfirstlane(tid >> 6), lane = tid & 63, wr = wid >> 2, wc = wid & 3, fr = lane & 15, fq = lane >> 4;
    const int K = g.K, nt = K / BK;
    unsigned voffA[2], voffB[2];
#pragma unroll
    for (int i = 0; i < 2; ++i) { int R, C; stage_rc(tid * 16 + i * 8192, R, C); const int Rb = Epi::PERM ? ((R & ~31) + perm32(R & 31)) : R;
        voffA[i] = (unsigned)(R * K + C) * 2u; voffB[i] = (unsigned)(Rb * K + C) * 2u; }
    const size_t kstep = (size_t)(BK * 2);
    const size_t hstep = (size_t)HALF * K * 2;
    const size_t tstep = 2 * hstep;
    const unsigned ldsw = (unsigned)wid * 1024u;
    const int aoff = lds_byte(wr * 64 + fr, fq * 8), boff = lds_byte(wc * 32 + fr, fq * 8);
#define PG8_SA(b, h) (((b) * 2 + (h)) * HTB)
#define PG8_SB(b, h) ((4 + (b) * 2 + (h)) * HTB)
#define PG8_STAGE(bufoff, gbase, voff) do { _Pragma("unroll") for (int _i = 0; _i < 2; ++_i) \
        __builtin_amdgcn_global_load_lds((const unsigned*)((const char*)(gbase) + (voff)[_i]), (PG8_LAS unsigned*)(lds + (bufoff) + ldsw + _i * 8192), 16, 0, 0); } while (0)
#define PG8_LDA(dst, b, h) do { _Pragma("unroll") for (int m = 0; m < 4; ++m) _Pragma("unroll") for (int k = 0; k < 2; ++k) dst[m][k] = *(const PG8_LAS bf16x8*)(lds + PG8_SA(b, h) + aoff + m * 2048 + k * 1024); } while (0)
#define PG8_LDB(dst, b, h) do { _Pragma("unroll") for (int n = 0; n < 2; ++n) _Pragma("unroll") for (int k = 0; k < 2; ++k) dst[n][k] = *(const PG8_LAS bf16x8*)(lds + PG8_SB(b, h) + boff + n * 2048 + k * 1024); } while (0)
#define PG8_MMA(ai, bj, At, Bt) do { __builtin_amdgcn_s_setprio(1); _Pragma("unroll") for (int m = 0; m < 4; ++m) _Pragma("unroll") for (int n = 0; n < 2; ++n) _Pragma("unroll") for (int k = 0; k < 2; ++k) \
        acc[ai][bj][m][n] = __builtin_amdgcn_mfma_f32_16x16x32_bf16(Bt[n][k], At[m][k], acc[ai][bj][m][n], 0, 0, 0); __builtin_amdgcn_s_setprio(0); } while (0)
#define PG8_WAIT_V(n) asm volatile("s_waitcnt vmcnt(" #n ")" ::: "memory")
#define PG8_WAIT_L(n) asm volatile("s_waitcnt lgkmcnt(" #n ")" ::: "memory")
#define PG8_BAR __builtin_amdgcn_s_barrier()
#define PG8_SCHED __builtin_amdgcn_sched_barrier(0)
    Unit cur, nxt; int ui = 0;
    if (!S.next(0, cur)) return;
    f32x4 acc[2][2][4][2];
#pragma unroll
    for (int a = 0; a < 2; ++a)
#pragma unroll
        for (int b = 0; b < 2; ++b)
#pragma unroll
            for (int m = 0; m < 4; ++m)
#pragma unroll
                for (int n = 0; n < 2; ++n) acc[a][b][m][n] = (f32x4){0.f, 0.f, 0.f, 0.f};
    bf16x8 At[4][2], B0[2][2], B1[2][2];
    const char* cA = (const char*)g.A + (size_t)cur.pm * tstep; const char* cB = (const char*)g.Bt + (size_t)cur.pn * tstep;
    S.a_ready(cur);
    if constexpr (SP2) {
        PG8_STAGE(PG8_SB(0, 0), cB, voffB); PG8_STAGE(PG8_SB(0, 1), cB + hstep, voffB); PG8_STAGE(PG8_SA(0, 0), cA, voffA); PG8_STAGE(PG8_SA(0, 1), cA + hstep, voffA);
        if (wr == 1) PG8_BAR;
        PG8_WAIT_V(2); PG8_BAR;
        PG8_STAGE(PG8_SB(1, 0), cB + kstep, voffB); PG8_STAGE(PG8_SA(1, 0), cA + kstep, voffA); PG8_STAGE(PG8_SB(1, 1), cB + hstep + kstep, voffB);
        PG8_WAIT_V(6); PG8_BAR;
    } else {
        PG8_STAGE(PG8_SB(0, 0), cB, voffB); PG8_STAGE(PG8_SA(0, 0), cA, voffA); PG8_STAGE(PG8_SB(0, 1), cB + hstep, voffB); PG8_STAGE(PG8_SA(0, 1), cA + hstep, voffA);
        if (wr == 1) PG8_BAR;
        PG8_WAIT_V(4); PG8_BAR;
        PG8_STAGE(PG8_SB(1, 0), cB + kstep, voffB); PG8_STAGE(PG8_SA(1, 0), cA + kstep, voffA); PG8_STAGE(PG8_SB(1, 1), cB + hstep + kstep, voffB);
        PG8_WAIT_V(6); PG8_BAR;
    }
    for (;;) {
        const bool has_next = S.next(ui + 1, nxt);
        const char* nA = has_next ? (const char*)g.A + (size_t)nxt.pm * tstep : cA; const char* nB = has_next ? (const char*)g.Bt + (size_t)nxt.pn * tstep : cB;
        for (int t = 0; t < nt; t += 2) {
            const bool last = (t == nt - 2);
            const char* a1 = cA + (size_t)(t + 1) * kstep;
            const char* a2 = last ? nA : cA + (size_t)(t + 2) * kstep; const char* b2 = last ? nB : cB + (size_t)(t + 2) * kstep;
            const char* a3 = a2 + kstep; const char* b3 = b2 + kstep;
            if (last && has_next) S.a_ready(nxt);
            if constexpr (SP2) {
            PG8_LDB(B0, 0, 0); PG8_LDB(B1, 0, 1); PG8_SCHED; PG8_LDA(At, 0, 0); PG8_STAGE(PG8_SA(1, 1), a1 + hstep, voffA);
            PG8_WAIT_V(8); PG8_WAIT_L(0); PG8_BAR; PG8_MMA(0, 0, At, B0); PG8_MMA(0, 1, At, B1); PG8_BAR; PG8_SCHED;
            PG8_LDA(At, 0, 1); PG8_STAGE(PG8_SB(0, 0), b2, voffB); PG8_STAGE(PG8_SB(0, 1), b2 + hstep, voffB); PG8_STAGE(PG8_SA(0, 0), a2, voffA);
            PG8_WAIT_V(8); PG8_WAIT_L(0); PG8_BAR; PG8_MMA(1, 0, At, B0); PG8_MMA(1, 1, At, B1); PG8_BAR; PG8_SCHED;
            PG8_LDB(B0, 1, 0); PG8_LDB(B1, 1, 1); PG8_SCHED; PG8_LDA(At, 1, 0); PG8_STAGE(PG8_SA(0, 1), a2 + hstep, voffA);
            PG8_WAIT_V(8); PG8_WAIT_L(0); PG8_BAR; PG8_MMA(0, 0, At, B0); PG8_MMA(0, 1, At, B1); PG8_BAR; PG8_SCHED;
            PG8_LDA(At, 1, 1); PG8_STAGE(PG8_SB(1, 0), b3, voffB); PG8_STAGE(PG8_SB(1, 1), b3 + hstep, voffB); PG8_STAGE(PG8_SA(1, 0), a3, voffA);
            PG8_WAIT_V(8); PG8_WAIT_L(0); PG8_BAR; PG8_MMA(1, 0, At, B0); PG8_MMA(1, 1, At, B1); PG8_BAR; PG8_SCHED;
            } else {
            PG8_LDB(B0, 0, 0); PG8_SCHED; PG8_LDA(At, 0, 0); PG8_STAGE(PG8_SA(1, 1), a1 + hstep, voffA);
            PG8_WAIT_L(8); PG8_BAR; PG8_WAIT_L(0); PG8_MMA(0, 0, At, B0); PG8_BAR; PG8_SCHED;
            PG8_LDB(B1, 0, 1); PG8_STAGE(PG8_SB(0, 0), b2, voffB);
            PG8_BAR; PG8_WAIT_L(0); PG8_MMA(0, 1, At, B1); PG8_BAR;
            PG8_LDA(At, 0, 1); PG8_STAGE(PG8_SA(0, 0), a2, voffA);
            PG8_BAR; PG8_WAIT_L(0); PG8_MMA(1, 0, At, B0); PG8_BAR; PG8_SCHED;
            PG8_STAGE(PG8_SB(0, 1), b2 + hstep, voffB);
            PG8_WAIT_V(6); PG8_BAR; PG8_MMA(1, 1, At, B1); PG8_BAR;
            PG8_LDB(B0, 1, 0); PG8_SCHED; PG8_LDA(At, 1, 0); PG8_STAGE(PG8_SA(0, 1), a2 + hstep, voffA);
            PG8_WAIT_L(8); PG8_BAR; PG8_WAIT_L(0); PG8_MMA(0, 0, At, B0); PG8_BAR; PG8_SCHED;
            PG8_LDB(B1, 1, 1); PG8_STAGE(PG8_SB(1, 0), b3, voffB);
            PG8_BAR; PG8_WAIT_L(0); PG8_MMA(0, 1, At, B1); PG8_BAR;
            PG8_LDA(At, 1, 1); PG8_STAGE(PG8_SA(1, 0), a3, voffA);
            PG8_BAR; PG8_WAIT_L(0); PG8_MMA(1, 0, At, B0); PG8_BAR; PG8_SCHED;
            PG8_STAGE(PG8_SB(1, 1), b3 + hstep, voffB);
            PG8_WAIT_V(6); PG8_BAR; PG8_MMA(1, 1, At, B1); PG8_BAR;
            }
        }
        if constexpr (ALIGN_EPI) { if (wr == 0) PG8_BAR; }
        if constexpr (!Epi::AFTER_DRAIN) { E(acc, cur, wr, wc, fr, fq); S.done(cur); }
        if (!has_next) break;
#pragma unroll
        for (int a = 0; a < 2; ++a)
#pragma unroll
            for (int b = 0; b < 2; ++b)
#pragma unroll
                for (int m = 0; m < 4; ++m)
#pragma unroll
                    for (int n = 0; n < 2; ++n) acc[a][b][m][n] = (f32x4){0.f, 0.f, 0.f, 0.f};
        cur = nxt; cA = nA; cB = nB; ++ui;
        if constexpr (ALIGN_EPI) { if (wr == 1) PG8_BAR; }
    }
    PG8_WAIT_V(0);
    if constexpr (!ALIGN_EPI) { if (wr == 0) PG8_BAR; }
    PG8_BAR;
    if constexpr (Epi::AFTER_DRAIN) { E.fused(acc, cur, wr, wc, fr, fq, lds, wid, lane); S.done(cur); }
#undef PG8_SA
#undef PG8_SB
#undef PG8_STAGE
#undef PG8_LDA
#undef PG8_LDB
#undef PG8_MMA
#undef PG8_WAIT_V
#undef PG8_WAIT_L
#undef PG8_BAR
#undef PG8_SCHED
}
}
#endif

#ifdef HOST_EMU
template <class Epi, class Sched, bool A_ = false, bool B_ = false>
void gemm_phase(unsigned char*, const Gemm g, const Sched& S, const Epi& E) {
    const int tid = threadIdx.x, wid = tid >> 6, lane = tid & 63, wr = wid >> 2, wc = wid & 3, fr = lane & 15, fq = lane >> 4;
    const int nN = g.N / 256, nU = (g.M / 256) * nN;
    for (int u = S.c; u < nU; u += S.G) { Unit un{u / nN, u % nN}; f32x4 acc[2][2][4][2];
        for (int ai = 0; ai < 2; ++ai) for (int bj = 0; bj < 2; ++bj) for (int m = 0; m < 4; ++m) for (int n = 0; n < 2; ++n) for (int i = 0; i < 4; ++i) {
            const int row = un.pm * 256 + 128 * ai + 64 * wr + 16 * m + fr, col = un.pn * 256 + 128 * bj + 32 * wc + (Epi::PERM ? 8 * fq + 4 * n + i : 16 * n + 4 * fq + i);
            float s = 0.f; for (int k = 0; k < g.K; ++k) s += bf2f(g.A[(size_t)row * g.K + k]) * bf2f(g.Bt[(size_t)col * g.K + k]);
            acc[ai][bj][m][n][i] = s; }
        E(acc, un, wr, wc, fr, fq); }
}
}
#endif
#ifndef PG8_SP2
#define PG8_SP2 true
#endif
#ifndef PG8_ALIGN
#define PG8_ALIGN true
#endif

constexpr int NWAVES = 8, NTHR = NWAVES * 64;
enum Phase { PH_PRO = 0, PH_EIN, PH_EMA, PH_EMB, PH_EMC, PH_EOUT, PH_LN1A, PH_UP0, PH_CG0, PH_DN0, PH_LN2A,
             PH_OIN, PH_OMA, PH_OMB, PH_OMC, PH_OMD, PH_OOUT, PH_LN1B, PH_UP1, PH_CG1, PH_DN1, PH_LN2B, NPH };
#ifndef MK_ONE_LAUNCH
#define MK_ONE_LAUNCH 1
#endif

constexpr size_t alup(size_t x) { return (x + 4095) & ~(size_t)4095; }
constexpr size_t WS_CTL = 0, CTL_ZERO_BYTES = 1u << 20;
constexpr size_t WS_WEIN = CTL_ZERO_BYTES,                 SZ_WEIN = alup((size_t)EIN_P * DM * 2);
constexpr size_t WS_WEOUT = WS_WEIN + SZ_WEIN,             SZ_WEOUT = alup((size_t)DM * EMIX * 2);
constexpr size_t WS_WOIN = WS_WEOUT + SZ_WEOUT,            SZ_WOIN = alup((size_t)OIN_P * DM * 2);
constexpr size_t WS_WOOUT = WS_WOIN + SZ_WOIN,             SZ_WOOUT = alup((size_t)DM * OMIX * 2);
constexpr size_t WS_WUP = WS_WOOUT + SZ_WOOUT,             SZ_WUP1 = alup((size_t)FF2 * DM * 2);
constexpr size_t WS_WDN = WS_WUP + NLAYER * SZ_WUP1,       SZ_WDN1 = alup((size_t)DM * FF * 2);
constexpr size_t WS_XB = WS_WDN + NLAYER * SZ_WDN1,        SZ_XB = alup((size_t)T * DM * 2);
constexpr size_t WS_WLT = WS_XB + SZ_XB,                 SZ_WLT = alup((size_t)2 * LNB * 2 * 128 * 128 * 2);
constexpr size_t WS_STATS = WS_WLT + SZ_WLT,             SZ_STATS = alup((size_t)T * 2 * 4);
constexpr size_t WS_OVL = WS_STATS + SZ_STATS;
constexpr size_t WS_H = WS_OVL,                            SZ_H = alup((size_t)(T / 256) * 4 * FF2 * 4);
constexpr size_t WS_ACT = WS_H + SZ_H,                     SZ_ACT = alup((size_t)T * FF * 2);
constexpr int PROJ_LD = EIN_P > OIN_P ? EIN_P : OIN_P, MIX_LD = EMIX > OMIX ? EMIX : OMIX;
constexpr size_t WS_PROJ = WS_OVL,                         SZ_PROJ = alup((size_t)T * PROJ_LD * 2);
constexpr size_t WS_MIX = WS_PROJ + SZ_PROJ,               SZ_MIX = alup((size_t)T * MIX_LD * 2);
constexpr size_t WS_SCR = WS_MIX + SZ_MIX;
constexpr size_t WS_END_FFN = WS_ACT + SZ_ACT;
constexpr int CW_TMO = 0, CW_BAR = 4096;

constexpr int RING_OFF = 0, RING_BYTES = 131072;
constexpr int LDSCTL_OFF = RING_BYTES, MISC_OFF = LDSCTL_OFF + 320, EDGE_OFF = LDSCTL_OFF + 1024;
constexpr int LDS_BYTES = 147456;

typedef GAS unsigned gu32;
#define RLX_AGENT __ATOMIC_RELAXED, __HIP_MEMORY_SCOPE_AGENT

#ifndef HOST_EMU
#define XB_TMO      128
#define XB_XCNT(j)  (256  + 64 * (j))
#define XB_XSUB(j)  (1280 + 64 * (j))
#define XB_XGEN(j)  (2304 + 64 * (j))
#define XB_TOP      3328
#define XB_TOPGEN   3392
#define XCD_BAR_WORDS 3456
#define XB_SPIN_CAP (1u << 18)

__device__ __forceinline__ unsigned xb_ld(unsigned* p)              { return __hip_atomic_load(p, __ATOMIC_RELAXED, __HIP_MEMORY_SCOPE_AGENT); }
__device__ __forceinline__ unsigned xb_add(unsigned* p, unsigned v) { return __hip_atomic_fetch_add(p, v, __ATOMIC_RELAXED, __HIP_MEMORY_SCOPE_AGENT); }
__device__ __forceinline__ unsigned xb_xcc_id() { return (unsigned)__builtin_amdgcn_s_getreg((3 << 11) | 20) & 0xFu; }
#define XB_SPIN(cond, bar) do { unsigned _sp = 0; while (cond) { __builtin_amdgcn_s_sleep(1); \
    if ((++_sp & 255u) == 0u) { if (xb_ld(&(bar)[XB_TMO])) break; if (_sp > XB_SPIN_CAP) { atomicAdd(&(bar)[XB_TMO], 1u); break; } } } } while (0)

struct XcdBarrier {
    unsigned* bar; unsigned x;
    volatile LAS unsigned* st;
};

__device__ __forceinline__ XcdBarrier xcd_barrier_post(unsigned* bar, volatile LAS unsigned* st) {
    XcdBarrier b; b.bar = bar; b.x = xb_xcc_id(); b.st = st;
    if (threadIdx.x == 0) (void)xb_add(&bar[XB_XCNT(b.x)], 1u);
    return b;
}
__device__ __forceinline__ void xcd_barrier_complete(unsigned* bar, unsigned x, unsigned& nloc, unsigned& nx) {
    const unsigned G = gridDim.x * gridDim.y * gridDim.z;
    unsigned sum, cnt, mine, sp = 0u;
    for (;;) {
        sum = 0u; cnt = 0u; mine = 0u;
#pragma unroll
        for (unsigned j = 0; j < 16; ++j) { const unsigned c = xb_ld(&bar[XB_XCNT(j)]); sum += c; cnt += (c > 0u) ? 1u : 0u; mine = (j == x) ? c : mine; }
        if (sum == G) break;
        __builtin_amdgcn_s_sleep(1);
        if ((++sp & 255u) == 0u) { if (xb_ld(&bar[XB_TMO])) break; if (sp > XB_SPIN_CAP) { atomicAdd(&bar[XB_TMO], 1u); break; } }
    }
    nloc = mine > 0u ? mine : 1u; nx = cnt > 0u ? cnt : 1u;
}

__device__ __forceinline__ void xcd_barrier(const XcdBarrier& b) {
    asm volatile("s_waitcnt vmcnt(0)" ::: "memory");
    __syncthreads();
    if (threadIdx.x == 0) {
        unsigned* bar = b.bar;
        __builtin_amdgcn_s_waitcnt(0);
        unsigned nloc = b.st[0], nx = b.st[1];
        if (nloc == 0u) { xcd_barrier_complete(bar, b.x, nloc, nx); b.st[0] = nloc; b.st[1] = nx; }
        const unsigned old = xb_add(&bar[XB_XSUB(b.x)], 1u);
        const unsigned gen = old / nloc;
        if (old + 1u == (gen + 1u) * nloc) {
            __builtin_amdgcn_fence(__ATOMIC_RELEASE, "agent");
            asm volatile("s_waitcnt vmcnt(0)" ::: "memory");
            const unsigned og = xb_add(&bar[XB_TOP], 1u);
            const unsigned tg = og / nx;
            if (og + 1u == (tg + 1u) * nx) xb_add(&bar[XB_TOPGEN], 1u);
            else XB_SPIN(xb_ld(&bar[XB_TOPGEN]) == tg, bar);
            __builtin_amdgcn_fence(__ATOMIC_ACQUIRE, "agent");
            xb_add(&bar[XB_XGEN(b.x)], 1u);
            asm volatile("s_waitcnt vmcnt(0)" ::: "memory");
        } else {
            XB_SPIN(xb_ld(&bar[XB_XGEN(b.x)]) == gen, bar);
            __builtin_amdgcn_fence(__ATOMIC_ACQUIRE, "agent");
            asm volatile("s_waitcnt vmcnt(0)" ::: "memory");
        }
    }
    __syncthreads();
}

#endif

struct Frame {
    LAS unsigned char* lds;
    volatile LAS unsigned* MISC;
    gu32* ctl;
    int tid, lane, wave;
    int vcu, G;
    float* out; unsigned char* ws;
};
DI float wave_sum(float v) {
#pragma unroll
    for (int o = 1; o < 64; o <<= 1) v += __shfl_xor(v, o);
    return v;
}

DI void p0_transpose_item(const float* W, int K, int N, bf16* WT, LAS float* scr, int item, int lane, int gate_ff = 0) {
    const int nblk = N / 32, kb = item / nblk, nb = item % nblk, k0 = 64 * kb, n0 = 32 * nb;
    const int r0 = gate_ff ? (n0 < gate_ff ? (n0 / 128) * 256 + n0 % 128 : ((n0 - gate_ff) / 128) * 256 + 128 + (n0 - gate_ff) % 128) : n0;
#pragma unroll 8
    for (int i = 0; i < 32; ++i) { const int kk = 2 * i + (lane >> 5); scr[kk * 33 + (lane & 31)] = W[(size_t)(k0 + kk) * N + n0 + (lane & 31)]; }
    WAVE_SYNC();
    const int c = lane & 7;
#pragma unroll
    for (int j = 0; j < 4; ++j) { const int n = (lane >> 3) + 8 * j; const LAS float* s = scr + (8 * c) * 33 + n;
        v4u o; o.x = pk2(s[0 * 33], s[1 * 33]); o.y = pk2(s[2 * 33], s[3 * 33]); o.z = pk2(s[4 * 33], s[5 * 33]); o.w = pk2(s[6 * 33], s[7 * 33]);
        *(v4u*)(WT + (size_t)(r0 + n) * K + k0 + 8 * c) = o; }
    WAVE_SYNC();
}
DI void zero_fill16(Frame& F, void* p, size_t bytes) {
    v4u* q = (v4u*)p; const size_t n = bytes / 16; const v4u z = {0u, 0u, 0u, 0u};
    for (size_t i = (size_t)F.vcu * NTHR + F.tid; i < n; i += (size_t)F.G * NTHR) q[i] = z;
}
struct WSrc { const float *w_ein, *w_eout, *w_oin, *w_oout, *w_up, *w_dn; };
constexpr int I_EIN = (DM / 64) * (EIN / 32), I_EOUT = (EMIX / 64) * (DM / 32), I_OIN = (DM / 64) * (OIN / 32), I_OOUT = (OMIX / 64) * (DM / 32);
constexpr int I_UP = (DM / 64) * (FF2 / 32), I_DN = (FF / 64) * (DM / 32);
constexpr int N_EARLY = I_EIN + I_EOUT + I_UP + I_DN, N_LATE = I_OIN + I_OOUT + I_UP + I_DN;
constexpr int LATE_A = N_LATE * 28 / 100, LATE_B = N_LATE * 36 / 100;
DI void conv_early_item(Frame& F, const WSrc& S, int r, LAS float* scr) {
    if (r < I_EIN) { p0_transpose_item(S.w_ein, DM, EIN, (bf16*)(F.ws + WS_WEIN), scr, r, F.lane); return; } r -= I_EIN;
    if (r < I_EOUT) { p0_transpose_item(S.w_eout, EMIX, DM, (bf16*)(F.ws + WS_WEOUT), scr, r, F.lane); return; } r -= I_EOUT;
    if (r < I_UP) { p0_transpose_item(S.w_up, DM, FF2, (bf16*)(F.ws + WS_WUP), scr, r, F.lane, FF); return; } r -= I_UP;
    p0_transpose_item(S.w_dn, FF, DM, (bf16*)(F.ws + WS_WDN), scr, r, F.lane);
}
DI void conv_late_item(Frame& F, const WSrc& S, int r, LAS float* scr) {
    if (r < I_OIN) { p0_transpose_item(S.w_oin, DM, OIN, (bf16*)(F.ws + WS_WOIN), scr, r, F.lane); return; } r -= I_OIN;
    if (r < I_OOUT) { p0_transpose_item(S.w_oout, OMIX, DM, (bf16*)(F.ws + WS_WOOUT), scr, r, F.lane); return; } r -= I_OOUT;
    if (r < I_UP) { p0_transpose_item(S.w_up + (size_t)DM * FF2, DM, FF2, (bf16*)(F.ws + WS_WUP + SZ_WUP1), scr, r, F.lane, FF); return; } r -= I_UP;
    p0_transpose_item(S.w_dn + (size_t)FF * DM, FF, DM, (bf16*)(F.ws + WS_WDN + SZ_WDN1), scr, r, F.lane);
}
DI void conv_late_tail(Frame& F, const WSrc& S, int nwg, int c, int lo, int hi) {
    const int rem = nwg % F.G;
    if (c < rem) return;
    LAS float* scr = (LAS float*)(F.lds + RING_OFF + F.wave * 16384);
    const int nl = (F.G - rem) * NWAVES;
    for (int it = lo + (c - rem) * NWAVES + F.wave; it < hi; it += nl) conv_late_item(F, S, it, scr);
}
DI void p0_prologue(Frame& F, const float* x_p, const float* x_s, const WSrc& S) {
    LAS float* scr = (LAS float*)(F.lds + RING_OFF + F.wave * 16384);
    const int gw = F.vcu * NWAVES + F.wave, NGW = F.G * NWAVES;
    for (int it = gw; it < N_EARLY; it += NGW) conv_early_item(F, S, it, scr);
    for (int it = LATE_A + LATE_B + gw; it < N_LATE; it += NGW) conv_late_item(F, S, it, scr);
    if (EIN_P > EIN) zero_fill16(F, (bf16*)(F.ws + WS_WEIN) + (size_t)EIN * DM, (size_t)(EIN_P - EIN) * DM * 2);
    if (OIN_P > OIN) zero_fill16(F, (bf16*)(F.ws + WS_WOIN) + (size_t)OIN * DM, (size_t)(OIN_P - OIN) * DM * 2);
    bf16* XB = (bf16*)(F.ws + WS_XB);
    const size_t nq = (size_t)T * DM / 4, npq = (size_t)NSEQ_P * SEQ * DM / 4;
    for (size_t i = (size_t)F.vcu * NTHR + F.tid; i < nq; i += (size_t)F.G * NTHR) {
        const v4f v = (i < npq) ? ((const v4f*)x_p)[i] : ((const v4f*)x_s)[i - npq];
        v2u o; o.x = pk2(v.x, v.y); o.y = pk2(v.z, v.w); ((v2u*)XB)[i] = o;
    }
}

template <bool FINAL> DI void ln_phase(Frame& F, const bf16* Y, float* Xout, bf16* XBo, float* stats, const float* g, const float* b) {
    constexpr int NV = DM / 256;
    static_assert(T % 2 == 0 && DM * 8 <= RING_BYTES, "ln_phase: row pairs, affine vectors in LDS");
    LAS v4f* gl = (LAS v4f*)(F.lds + RING_OFF); LAS v4f* bl = gl + DM / 4;
    __syncthreads();
    for (int i = F.tid; i < DM / 4; i += NTHR) { gl[i] = ((const v4f*)g)[i]; bl[i] = ((const v4f*)b)[i]; }
    __syncthreads();
    const int gw = F.vcu * NWAVES + F.wave, NGW = F.G * NWAVES;
#pragma unroll 1
    for (int m = 2 * gw; m < T; m += 2 * NGW) {
        const v2u* ya_ = (const v2u*)(Y + (size_t)m * DM) + F.lane; const v2u* yb_ = ya_ + DM / 4;
        v4f va[NV], vb[NV]; float sa = 0.f, sb = 0.f;
        { v2u ra_[NV], rb_[NV];
#pragma unroll
          for (int j = 0; j < NV; ++j) { ra_[j] = ya_[64 * j]; rb_[j] = yb_[64 * j]; }
#pragma unroll
          for (int j = 0; j < NV; ++j) { va[j] = (v4f){bflo(ra_[j].x), bfhi(ra_[j].x), bflo(ra_[j].y), bfhi(ra_[j].y)}; vb[j] = (v4f){bflo(rb_[j].x), bfhi(rb_[j].x), bflo(rb_[j].y), bfhi(rb_[j].y)}; } }
#pragma unroll
        for (int j = 0; j < NV; ++j) { sa += (va[j].x + va[j].y) + (va[j].z + va[j].w); sb += (vb[j].x + vb[j].y) + (vb[j].z + vb[j].w); }
#pragma unroll
        for (int o = 1; o < 64; o <<= 1) { const float ta = __shfl_xor(sa, o), tb = __shfl_xor(sb, o); sa += ta; sb += tb; }
        const float ma = sa * (1.f / DM), mb = sb * (1.f / DM); float qa = 0.f, qb = 0.f;
#pragma unroll
        for (int j = 0; j < NV; ++j) { va[j] = va[j] - ma; vb[j] = vb[j] - mb;
            qa += (va[j].x * va[j].x + va[j].y * va[j].y) + (va[j].z * va[j].z + va[j].w * va[j].w); qb += (vb[j].x * vb[j].x + vb[j].y * vb[j].y) + (vb[j].z * vb[j].z + vb[j].w * vb[j].w); }
#pragma unroll
        for (int o = 1; o < 64; o <<= 1) { const float ta = __shfl_xor(qa, o), tb = __shfl_xor(qb, o); qa += ta; qb += tb; }
        const float ra = frsq(qa * (1.f / DM) + LN_EPS), rb = frsq(qb * (1.f / DM) + LN_EPS);
        if (!FINAL && F.lane == 0) { *(v4f*)(stats + 2 * m) = (v4f){ma, ra, mb, rb}; }
        v2u* oa = (v2u*)(XBo + (size_t)m * DM) + F.lane; v2u* ob = oa + DM / 4;
#pragma unroll
        for (int j = 0; j < NV; ++j) { if ((j & 3) == 0) CFENCE();
            const v4f gg = gl[F.lane + 64 * j], bb = bl[F.lane + 64 * j];
            const v4f ya = va[j] * ra * gg + bb, yb = vb[j] * rb * gg + bb;
            if (FINAL) { v4f* xa = (v4f*)(Xout + (size_t)m * DM) + F.lane; xa[64 * j] = ya; xa[DM / 4 + 64 * j] = yb; }
            else { v2u o; o.x = pk2(ya.x, ya.y); o.y = pk2(ya.z, ya.w); oa[64 * j] = o; o.x = pk2(yb.x, yb.y); o.y = pk2(yb.z, yb.w); ob[64 * j] = o; } }
    }
}

static_assert(FF % 128 == 0 && SEQ % 256 == 0, "fused conv+gate tiling");
DI void convgate_fix_phase(Frame& F, const float* EDGEG, bf16* ACT, const float* cw, const float* cb) {
    constexpr int NT = T / 256, NQ = FF / 4;
    const size_t total = (size_t)NT * 2 * NQ;
    for (size_t idx = (size_t)F.vcu * NTHR + F.tid; idx < total; idx += (size_t)F.G * NTHR) {
        const int q = (int)(idx % NQ), which = (int)((idx / NQ) & 1), pm = (int)(idx / (2 * NQ));
        const int c = 4 * q, pn = c / 128, lcol = c % 128, gi = pn * 256 + lcol, ui = gi + 128;
        const int row = pm * 256 + (which ? 255 : 0);
        const float* e = EDGEG + (size_t)pm * 4 * FF2;
        const v4f z = {0.f, 0.f, 0.f, 0.f};
        v4f gp, gc, gn, up, uc, un;
        if (!which) { const bool first = (row % SEQ) == 0;
            gp = first ? z : *(const v4f*)(e - (size_t)FF2 + gi); up = first ? z : *(const v4f*)(e - (size_t)FF2 + ui);
            gc = *(const v4f*)(e + gi); uc = *(const v4f*)(e + ui); gn = *(const v4f*)(e + FF2 + gi); un = *(const v4f*)(e + FF2 + ui);
        } else { const bool last = ((row + 1) % SEQ) == 0;
            gp = *(const v4f*)(e + 2 * (size_t)FF2 + gi); up = *(const v4f*)(e + 2 * (size_t)FF2 + ui); gc = *(const v4f*)(e + 3 * (size_t)FF2 + gi); uc = *(const v4f*)(e + 3 * (size_t)FF2 + ui);
            gn = last ? z : *(const v4f*)(e + 4 * (size_t)FF2 + gi); un = last ? z : *(const v4f*)(e + 4 * (size_t)FF2 + ui); }
        const v4f g = gp * *(const v4f*)(cw + c) + gc * *(const v4f*)(cw + FF2 + c) + gn * *(const v4f*)(cw + 2 * (size_t)FF2 + c) + *(const v4f*)(cb + c);
        const v4f u = up * *(const v4f*)(cw + FF + c) + uc * *(const v4f*)(cw + FF2 + FF + c) + un * *(const v4f*)(cw + 2 * (size_t)FF2 + FF + c) + *(const v4f*)(cb + FF + c);
        v2u o; o.x = pk2(siluf_(g.x) * u.x, siluf_(g.y) * u.y); o.y = pk2(siluf_(g.z) * u.z, siluf_(g.w) * u.w);
        *(v2u*)(ACT + (size_t)row * FF + c) = o;
    }
}

constexpr int NCH = SEQ / GCH;
constexpr int FN = 2 * SEQ, FNH = SEQ;
constexpr int NPAIR = NSEQ / 2;
static_assert(NSEQ % 2 == 0 && (FN & (FN - 1)) == 0, "hyena FFT geometry");
constexpr size_t WS_QD = WS_SCR,                 SZ_QD = alup((size_t)2 * T * GQK * 2);
constexpr size_t WS_KIT = WS_QD + SZ_QD,         SZ_KIT = SZ_QD;
constexpr size_t WS_SC = WS_KIT + SZ_KIT,        SZ_SC = alup((size_t)2 * NSEQ * NCH * GH * 64 * 64 * 2);
constexpr size_t WS_DEC = WS_SC + SZ_SC,         SZ_DEC = alup((size_t)2 * NSEQ * NCH * GH * 256 * 4);
constexpr size_t WS_OF = WS_DEC + SZ_DEC,        SZ_OF = alup((size_t)2 * T * GV * 4);
constexpr size_t WS_TW = WS_OF + SZ_OF,          SZ_TW = alup((size_t)FNH * 8);
constexpr size_t WS_H2 = WS_TW + SZ_TW,          SZ_H2 = alup((size_t)SEQ * HFH * 4);
constexpr size_t WS_KF = WS_H2 + SZ_H2,          SZ_KF = alup((size_t)HW * FN * 8);
constexpr size_t WS_UT = WS_KF + SZ_KF,          SZ_UT = alup((size_t)NSEQ * HW * SEQ * 4);
constexpr size_t WS_END_EVEN = WS_UT + SZ_UT;
static_assert((size_t)NSEQ * HW * SEQ * 4 <= SZ_XB, "YT fits in XB");

DI v4f mma16(v8s a, v8s b, v4f c) { return __builtin_amdgcn_mfma_f32_16x16x32_bf16(a, b, c, 0, 0, 0); }
DI v8s ldfrag(const LAS bf16* base, int row, int ld, int k0) { return *(const LAS v8s*)(base + row * ld + k0); }

DI void hyena_pro(Frame& F, const float* w1, const float* b1, const float* w2, const float* b2) {
    float* H2 = (float*)(F.ws + WS_H2); v2f* TW = (v2f*)(F.ws + WS_TW);
    const int gt = F.vcu * NTHR + F.tid, NT = F.G * NTHR;
    for (int k = gt; k < FNH; k += NT) { float s, c; sincospif((float)k * (2.0f / (float)FN), &s, &c); TW[k] = (v2f){c, -s}; }
    LAS float* h1 = (LAS float*)(F.lds + RING_OFF);
    __syncthreads();
    const int j = F.tid & 63, rr = F.tid >> 6;
#pragma unroll 1
    for (int t0 = F.vcu * 8; t0 < SEQ; t0 += F.G * 8) {
        const int t = t0 + rr;
        float acc = b1[j];
        {   const float tl = (float)t / (float)(SEQ - 1);
            acc += tl * w1[j];
            const float w = 6.283185307179586f * (float)t / (float)SEQ;
#pragma unroll 4
            for (int b = 0; b < HBANDS; ++b) { const float band = 1e-4f + (float)b * ((float)(HBANDS - 1) - 1e-4f) / (float)(HBANDS - 1);
                const float ang = band * w; acc += cosf(ang) * w1[(1 + b) * HFH + j] - sinf(ang) * w1[(1 + HBANDS + b) * HFH + j]; }
        }
        h1[rr * 64 + j] = sinf(acc);
        __syncthreads();
        float a2 = b2[j];
#pragma unroll 8
        for (int i = 0; i < HFH; ++i) a2 += h1[rr * 64 + i] * w2[i * HFH + j];
        H2[(size_t)t * HFH + j] = sinf(a2);
        __syncthreads();
    }
}

constexpr int ilog2c(int n) { return n <= 1 ? 0 : 1 + ilog2c(n >> 1); }
constexpr int LOGFN = ilog2c(FN), NP16 = LOGFN / 4;
static_assert(LOGFN % 4 == 1, "FFT: radix-16 passes plus exactly one radix-2 stage");
#define PH(i) ((i) + ((i) >> 5))
DI v2f cmul(v2f a, v2f b) { return (v2f){a.x * b.x - a.y * b.y, a.x * b.y + a.y * b.x}; }
DI v2f cmulc(v2f a, v2f b) { return (v2f){a.x * b.x + a.y * b.y, a.y * b.x - a.x * b.y}; }
#define R16C(k) ((k) == 0 ? 1.0f : (k) == 1 ? 0.9238795325112867f : (k) == 2 ? 0.7071067811865476f : (k) == 3 ? 0.3826834323650898f : (k) == 4 ? 0.0f : (k) == 5 ? -0.3826834323650898f : (k) == 6 ? -0.7071067811865476f : -0.9238795325112867f)
#define R16S(k) ((k) == 0 ? 0.0f : (k) == 1 ? -0.3826834323650898f : (k) == 2 ? -0.7071067811865476f : (k) == 3 ? -0.9238795325112867f : (k) == 4 ? -1.0f : (k) == 5 ? -0.9238795325112867f : (k) == 6 ? -0.7071067811865476f : -0.3826834323650898f)
constexpr int fft_twoff(int p) { return p == 0 ? 0 : fft_twoff(p - 1) + (FN >> (4 * p)); }
constexpr int FFT_NTW = fft_twoff(NP16);
template <int P, bool INV> DI void fft_pass16(LAS v2f* d, const LAS v2f* tw, int tid) {
    constexpr int Q = FN >> (4 * (P + 1));
    for (int g = tid; g < FN / 16; g += NTHR) {
        const int q = g % Q, base = (g / Q) * (16 * Q) + q;
        v2f x[16];
#pragma unroll
        for (int m = 0; m < 16; ++m) x[m] = d[PH(base + Q * m)];
        v2f bs[4]; bs[0] = tw[fft_twoff(P) + q]; bs[1] = cmul(bs[0], bs[0]); bs[2] = cmul(bs[1], bs[1]); bs[3] = cmul(bs[2], bs[2]);
#pragma unroll
        for (int s0 = 0; s0 < 4; ++s0) { const int s = INV ? 3 - s0 : s0, dist = 8 >> s;
#pragma unroll
            for (int m = 0; m < 16; ++m) if ((m & dist) == 0) { const int r = m & (dist - 1), kk = r * (8 / dist);
                const v2f w = cmul(bs[s], (v2f){R16C(kk), R16S(kk)});
                if (!INV) { const v2f a = x[m], b = x[m + dist]; x[m] = a + b; x[m + dist] = cmul(a - b, w); }
                else { const v2f a = x[m], b = cmulc(x[m + dist], w); x[m] = a + b; x[m + dist] = a - b; } } }
#pragma unroll
        for (int m = 0; m < 16; ++m) d[PH(base + Q * m)] = x[m];
    }
    __syncthreads();
}
DI void fft_last2(LAS v2f* d, int tid) {
    for (int g = tid; g < FN / 2; g += NTHR) { const int i = PH(2 * g); const v2f a = d[i], b = d[i + 1]; d[i] = a + b; d[i + 1] = a - b; }
    __syncthreads();
}
template <int P> DI void fft_dif_from(LAS v2f* d, const LAS v2f* tw, int tid) { if constexpr (P < NP16) { fft_pass16<P, false>(d, tw, tid); fft_dif_from<P + 1>(d, tw, tid); } }
template <int P> DI void fft_idit_from(LAS v2f* d, const LAS v2f* tw, int tid) { if constexpr (P >= 0) { fft_pass16<P, true>(d, tw, tid); fft_idit_from<P - 1>(d, tw, tid); } }
DI void fft_dif(LAS v2f* d, const LAS v2f* tw, int tid) { fft_dif_from<0>(d, tw, tid); fft_last2(d, tid); }
constexpr int NMID = FN / 2 / NTHR > 0 ? FN / 2 / NTHR : 1;
DI void fft_mid_conv(LAS v2f* d, const v4f (&kf)[NMID], int tid) {
#pragma unroll
    for (int k = 0; k < NMID; ++k) { const int g = tid + NTHR * k; if (g < FN / 2) { const int i = PH(2 * g); const v2f a = d[i], b = d[i + 1];
        const v2f p = cmul(a + b, (v2f){kf[k].x, kf[k].y}), q = cmul(a - b, (v2f){kf[k].z, kf[k].w}); d[i] = p + q; d[i + 1] = p - q; } }
    __syncthreads();
}
DI void fft_idit(LAS v2f* d, const LAS v2f* tw, int tid) { fft_last2(d, tid); fft_idit_from<NP16 - 1>(d, tw, tid); }
constexpr int FFT_D_OFF = 0, FFT_TW_OFF = (FN + FN / 32) * 8, FFT_AUX_OFF = FFT_TW_OFF + ((FFT_NTW * 8 + 255) & ~255);
static_assert(FFT_AUX_OFF + 1024 <= RING_BYTES, "fft lds");
DI void fft_load_tw(Frame& F) {
    const v2f* TW = (const v2f*)(F.ws + WS_TW); LAS v2f* tw = (LAS v2f*)(F.lds + FFT_TW_OFF);
    for (int k = F.tid; k < FFT_NTW; k += NTHR) { int p = 0; while (p + 1 < NP16 && k >= fft_twoff(p + 1)) ++p; tw[k] = TW[(k - fft_twoff(p)) << (4 * p)]; }
}
DI void hyena_filter_unit(Frame& F, int c, const float* w3) {
    LAS v2f* d = (LAS v2f*)(F.lds + FFT_D_OFF); const LAS v2f* tw = (const LAS v2f*)(F.lds + FFT_TW_OFF); LAS float* wc = (LAS float*)(F.lds + FFT_AUX_OFF);
    const float* H2 = (const float*)(F.ws + WS_H2);
    __syncthreads();
    if (F.tid < 128) wc[F.tid] = w3[(size_t)(F.tid & 63) * (2 * HW) + (F.tid >> 6) * HW + c];
    fft_load_tw(F);
    __syncthreads();
    const float min_decay = -3.0701134573253945f, max_decay = -15.350567286626972f;
    const float delta = min_decay + (max_decay - min_decay) * (float)c / (float)(HW - 1);
#pragma unroll 1
    for (int t = F.tid; t < SEQ; t += NTHR) {
        const v4f* hr = (const v4f*)(H2 + (size_t)t * HFH); float sf = 0.f, sb = 0.f;
#pragma unroll
        for (int q = 0; q < HFH / 4; ++q) { const v4f h = hr[q];
            sf += h.x * wc[4 * q] + h.y * wc[4 * q + 1] + h.z * wc[4 * q + 2] + h.w * wc[4 * q + 3];
            sb += h.x * wc[64 + 4 * q] + h.y * wc[64 + 4 * q + 1] + h.z * wc[64 + 4 * q + 2] + h.w * wc[64 + 4 * q + 3]; }
        const float win = __expf(-((float)t / (float)(SEQ - 1)) * fabsf(delta));
        d[PH(t)] = (v2f){sf * win, 0.f};
        if (t == 0) d[PH(SEQ)] = (v2f){0.f, 0.f}; else d[PH(FN - t)] = (v2f){sb * win, 0.f};
    }
    __syncthreads();
    fft_dif(d, tw, F.tid);
    v2f* KF = (v2f*)(F.ws + WS_KF) + (size_t)c * FN;
    for (int i = F.tid; i < FN; i += NTHR) KF[i] = d[PH(i)];
}
constexpr int HT = 128;
static_assert(SEQ % HT == 0 && NTHR % HT == 0 && HT % 8 == 0, "hyena tile");
DI void hyena_prep_unit(Frame& F, int unit, const float* cw, const float* cb) {
    constexpr int CT = HW / 64, TT = SEQ / HT, TPT = HT / 8, CG = NTHR / HT, CPT = 64 / CG;
    const int ct = unit % CT, tt = (unit / CT) % TT, seq = unit / (CT * TT);
    const bf16* PROJ = (const bf16*)(F.ws + WS_PROJ); bf16* UT = (bf16*)(F.ws + WS_UT);
    LAS float* tile = (LAS float*)(F.lds + RING_OFF);
    LAS bf16* raw = (LAS bf16*)(F.lds + RING_OFF + 64 * (HT + 1) * 4);
    const bf16* base = PROJ + (size_t)(seq * SEQ) * EIN_P + E_HY + ct * 64;
    __syncthreads();
    for (int q = F.tid; q < 2 * (HT + 2) * 8; q += NTHR) { const int ten = q / ((HT + 2) * 8), rem = q - ten * (HT + 2) * 8, row = rem >> 3, c8 = rem & 7, s = tt * HT - 1 + row;
        v4u v = {0u, 0u, 0u, 0u};
        if (s >= 0 && s < SEQ) v = *(const v4u*)(base + (size_t)s * EIN_P + (1 + ten) * HW + c8 * 8);
        *(LAS v4u*)(raw + (ten * (HT + 2) + row) * 64 + c8 * 8) = v; }
    const int cl = F.tid & 63, tq = F.tid >> 6, c = ct * 64 + cl;
    const int j1 = HW + c, jv = 2 * HW + c;
    const float w1a = cw[j1], w1b = cw[3 * HW + j1], w1c = cw[6 * HW + j1], b1 = cb[j1];
    const float wva = cw[jv], wvb = cw[3 * HW + jv], wvc = cw[6 * HW + jv], bv = cb[jv];
    __syncthreads();
#pragma unroll
    for (int i = 0; i < TPT; ++i) { const int r = tq * TPT + i + 1;
        const float x1 = bf2f(raw[(r - 1) * 64 + cl]) * w1a + bf2f(raw[r * 64 + cl]) * w1b + bf2f(raw[(r + 1) * 64 + cl]) * w1c + b1;
        const float v = bf2f(raw[(HT + 2 + r - 1) * 64 + cl]) * wva + bf2f(raw[(HT + 2 + r) * 64 + cl]) * wvb + bf2f(raw[(HT + 2 + r + 1) * 64 + cl]) * wvc + bv;
        tile[cl * (HT + 1) + tq * TPT + i] = v * x1; }
    __syncthreads();
    const int tp = F.tid % (HT / 2), cq = F.tid / (HT / 2);
#pragma unroll
    for (int i = 0; i < CPT / 2; ++i) { const int cc = cq * (CPT / 2) + i;
        ((unsigned*)(UT + ((size_t)seq * HW + ct * 64 + cc) * SEQ + tt * HT))[tp] = pk2(tile[cc * (HT + 1) + 2 * tp], tile[cc * (HT + 1) + 2 * tp + 1]); }
}
DI void hyena_conv_unit(Frame& F, int c, const float* bias) {
    LAS v2f* d = (LAS v2f*)(F.lds + FFT_D_OFF); const LAS v2f* tw = (const LAS v2f*)(F.lds + FFT_TW_OFF);
    const v2f* KF = (const v2f*)(F.ws + WS_KF) + (size_t)c * FN;
    constexpr int NU = SEQ / NTHR > 0 ? SEQ / NTHR : 1; static_assert(FN % NTHR == 0, "fft size vs block");
    v4f kf[NMID];
#pragma unroll
    for (int k = 0; k < NMID; ++k) { const int g = F.tid + NTHR * k; if (g < FN / 2) kf[k] = ((const v4f*)KF)[g]; }
    const unsigned* U = (const unsigned*)((const bf16*)(F.ws + WS_UT) + (size_t)c * SEQ); unsigned* Y = (unsigned*)((bf16*)(F.ws + WS_XB) + (size_t)c * SEQ);
    constexpr int NP2 = SEQ / 2 / NTHR > 0 ? SEQ / 2 / NTHR : 1; constexpr size_t SQW = (size_t)HW * SEQ / 2;
    unsigned ua[NP2], ub[NP2], na[NP2], nb[NP2];
#pragma unroll
    for (int k = 0; k < NP2; ++k) { const int t2 = F.tid + NTHR * k; if (t2 < SEQ / 2) { na[k] = U[t2]; nb[k] = U[SQW + t2]; } }
    const float bs = bias[c], sc = 1.0f / (float)FN;
    __syncthreads();
    fft_load_tw(F);
#pragma unroll 1
    for (int p = 0; p < NPAIR; ++p) {
        if (p) __syncthreads();
#pragma unroll
        for (int k = 0; k < NP2; ++k) { const int t2 = F.tid + NTHR * k; ua[k] = na[k]; ub[k] = nb[k];
            if (t2 < SEQ / 2) { d[PH(2 * t2)] = (v2f){bflo(ua[k]), bflo(ub[k])}; d[PH(2 * t2 + 1)] = (v2f){bfhi(ua[k]), bfhi(ub[k])}; d[PH(SEQ + 2 * t2)] = (v2f){0.f, 0.f}; d[PH(SEQ + 2 * t2 + 1)] = (v2f){0.f, 0.f}; } }
        if (p + 1 < NPAIR) {
#pragma unroll
            for (int k = 0; k < NP2; ++k) { const int t2 = F.tid + NTHR * k; if (t2 < SEQ / 2) { na[k] = U[(size_t)(2 * p + 2) * SQW + t2]; nb[k] = U[(size_t)(2 * p + 3) * SQW + t2]; } } }
        __syncthreads();
        fft_dif_from<0>(d, tw, F.tid);
        fft_mid_conv(d, kf, F.tid);
        fft_idit_from<NP16 - 1>(d, tw, F.tid);
#pragma unroll
        for (int k = 0; k < NP2; ++k) { const int t2 = F.tid + NTHR * k; if (t2 < SEQ / 2) { const v2f y0 = d[PH(2 * t2)], y1 = d[PH(2 * t2 + 1)];
            Y[(size_t)(2 * p) * SQW + t2] = pk2(y0.x * sc + bflo(ua[k]) * bs, y1.x * sc + bfhi(ua[k]) * bs); Y[(size_t)(2 * p + 1) * SQW + t2] = pk2(y0.y * sc + bflo(ub[k]) * bs, y1.y * sc + bfhi(ub[k]) * bs); } }
    }
}
DI void hyena_post_unit(Frame& F, int unit, const float* cw, const float* cb) {
    constexpr int CT = HW / 64, TT = SEQ / HT, TPT = HT / 8, CG = NTHR / HT, CPT = 64 / CG;
    const int ct = unit % CT, tt = (unit / CT) % TT, seq = unit / (CT * TT);
    const bf16* PROJ = (const bf16*)(F.ws + WS_PROJ); const bf16* YT = (const bf16*)(F.ws + WS_XB); bf16* MIX = (bf16*)(F.ws + WS_MIX);
    LAS float* tile = (LAS float*)(F.lds + RING_OFF);
    LAS bf16* raw = (LAS bf16*)(F.lds + RING_OFF + 64 * (HT + 1) * 4);
    LAS bf16* otile = raw + (HT + 2) * 64;
    static_assert(64 * (HT + 1) * 4 + 2 * (HT + 2) * 64 * 2 + HT * 72 * 2 <= RING_BYTES, "hyena tile lds");
    const bf16* base = PROJ + (size_t)(seq * SEQ) * EIN_P + E_HY + ct * 64;
    __syncthreads();
    { const int tp = F.tid % (HT / 2), cq = F.tid / (HT / 2);
#pragma unroll
      for (int i = 0; i < CPT / 2; ++i) { const int cc = cq * (CPT / 2) + i; const unsigned w = ((const unsigned*)(YT + ((size_t)seq * HW + ct * 64 + cc) * SEQ + tt * HT))[tp];
          tile[cc * (HT + 1) + 2 * tp] = bflo(w); tile[cc * (HT + 1) + 2 * tp + 1] = bfhi(w); } }
    for (int q = F.tid; q < (HT + 2) * 8; q += NTHR) { const int row = q >> 3, c8 = q & 7, s = tt * HT - 1 + row;
        v4u v = {0u, 0u, 0u, 0u};
        if (s >= 0 && s < SEQ) v = *(const v4u*)(base + (size_t)s * EIN_P + c8 * 8);
        *(LAS v4u*)(raw + row * 64 + c8 * 8) = v; }
    const int cl = F.tid & 63, tq = F.tid >> 6, c = ct * 64 + cl;
    const float wa = cw[c], wb = cw[3 * HW + c], wc = cw[6 * HW + c], b0 = cb[c];
    __syncthreads();
#pragma unroll
    for (int i = 0; i < TPT; ++i) { const int r = tq * TPT + i + 1;
        const float x0 = bf2f(raw[(r - 1) * 64 + cl]) * wa + bf2f(raw[r * 64 + cl]) * wb + bf2f(raw[(r + 1) * 64 + cl]) * wc + b0;
        otile[(tq * TPT + i) * 72 + cl] = (bf16)f2bf(tile[cl * (HT + 1) + tq * TPT + i] * x0); }
    __syncthreads();
    for (int q = F.tid; q < HT * 8; q += NTHR) { const int row = q >> 3, c8 = q & 7;
        *(v4u*)(MIX + (size_t)(seq * SEQ + tt * HT + row) * EMIX + GV + ct * 64 + c8 * 8) = *(const LAS v4u*)(otile + row * 72 + c8 * 8); }
}

constexpr int G_LD = 264, G_LDS = 72;
DI void gla_prep_unit(Frame& F, int unit, const float* wg_f, const float* bg_f, const float* wg_b, const float* bg_b) {
    const int h = unit % GH, n = (unit / GH) % NCH, seq = unit / (GH * NCH);
    const bf16* PROJ = (const bf16*)(F.ws + WS_PROJ);
    LAS float* lr = (LAS float*)(F.lds + RING_OFF);
    LAS float* tot = lr + 64 * 16;
    LAS bf16* QDl = (LAS bf16*)(F.lds + RING_OFF + 8192);
    LAS bf16* KIl = QDl + 64 * G_LD;
    const int t0 = seq * SEQ + n * GCH, d = F.tid & 255, hf = F.tid >> 8, l15 = F.lane & 15, l4 = F.lane >> 4;
#pragma unroll 1
    for (int dir = 0; dir < 2; ++dir) {
        const float* wg = dir ? wg_b : wg_f; const float* bg = dir ? bg_b : bg_f;
        __syncthreads();
        if (F.tid < 128) { const int s = F.tid >> 1, r8 = (F.tid & 1) * 8; const v4u v = *(const v4u*)(PROJ + (size_t)(t0 + s) * EIN_P + (dir ? E_LRB : E_LRF) + r8);
#pragma unroll
            for (int j = 0; j < 4; ++j) { lr[s * 16 + r8 + 2 * j] = bflo(v[j]); lr[s * 16 + r8 + 2 * j + 1] = bfhi(v[j]); } }
#pragma unroll
        for (int i = 0; i < 4; ++i) { const int q = F.tid + NTHR * i, row = q >> 5, c16 = q & 31;
            *(LAS v4u*)(QDl + row * G_LD + c16 * 8) = *(const v4u*)(PROJ + (size_t)(t0 + row) * EIN_P + E_Q + h * 256 + c16 * 8);
            *(LAS v4u*)(KIl + row * G_LD + c16 * 8) = *(const v4u*)(PROJ + (size_t)(t0 + row) * EIN_P + E_K + h * 256 + c16 * 8); }
        float w[16];
#pragma unroll
        for (int r = 0; r < 16; ++r) w[r] = wg[(size_t)r * GQK + h * 256 + d];
        const float bgd = bg[h * 256 + d];
        __syncthreads();
        float bl[32]; float acc = 0.f;
#pragma unroll
        for (int i = 0; i < 32; ++i) { const int ii = 32 * hf + i, s = dir ? 63 - ii : ii;
            float lg = bgd;
#pragma unroll
            for (int r4 = 0; r4 < 4; ++r4) { const v4f lv = *(const LAS v4f*)(lr + s * 16 + r4 * 4); lg += lv.x * w[4 * r4] + lv.y * w[4 * r4 + 1] + lv.z * w[4 * r4 + 2] + lv.w * w[4 * r4 + 3]; }
            const float la = ((lg < 0.f ? lg : 0.f) - __logf(1.f + __expf(-fabsf(lg)))) * (1.0f / 16.0f);
            acc += la; bl[i] = acc; }
        tot[hf * 256 + d] = acc;
        __syncthreads();
        const float off = hf ? tot[d] : 0.f, btot = tot[d] + tot[256 + d];
        bf16* QD = (bf16*)(F.ws + WS_QD) + (size_t)dir * T * GQK;
#pragma unroll
        for (int i = 0; i < 32; ++i) { const int ii = 32 * hf + i, s = dir ? 63 - ii : ii;
            const float b = bl[i] + off, e = __expf(b), ei = frcp(e);
            const float q = bf2f(QDl[s * G_LD + d]) * 0.0625f * e;
            const float k = bf2f(KIl[s * G_LD + d]) * ei;
            QDl[s * G_LD + d] = (bf16)f2bf(q); KIl[s * G_LD + d] = (bf16)f2bf(k); }
        const size_t cu = (((size_t)dir * NSEQ + seq) * NCH + n) * GH + h;
        if (hf == 0) ((float*)(F.ws + WS_DEC))[cu * 256 + d] = __expf(btot);
        __syncthreads();
#pragma unroll
        for (int i = 0; i < 4; ++i) { const int q = F.tid + NTHR * i, row = q >> 5, c16 = q & 31;
            *(v4u*)(QD + (size_t)(t0 + row) * GQK + h * 256 + c16 * 8) = *(const LAS v4u*)(QDl + row * G_LD + c16 * 8); }
        { bf16* KIT = (bf16*)(F.ws + WS_KIT) + cu * (256 * 64);
#pragma unroll
          for (int i = 0; i < 4; ++i) { const int q = F.tid + NTHR * i, dd = q >> 3, s8 = (q & 7) * 8; v4u o;
#pragma unroll
              for (int j = 0; j < 4; ++j) o[j] = (unsigned)KIl[(s8 + 2 * j) * G_LD + dd] | ((unsigned)KIl[(s8 + 2 * j + 1) * G_LD + dd] << 16);
              *(v4u*)(KIT + dd * 64 + s8) = o; } }
        { const int mt = F.wave & 3, ntp = F.wave >> 2; v4f a0 = {0.f, 0.f, 0.f, 0.f}, a1 = a0;
#pragma unroll
          for (int ks = 0; ks < 8; ++ks) { const v8s af = ldfrag(QDl, mt * 16 + l15, G_LD, ks * 32 + l4 * 8);
              a0 = mma16(af, ldfrag(KIl, (2 * ntp) * 16 + l15, G_LD, ks * 32 + l4 * 8), a0);
              a1 = mma16(af, ldfrag(KIl, (2 * ntp + 1) * 16 + l15, G_LD, ks * 32 + l4 * 8), a1); }
          bf16* SC = (bf16*)(F.ws + WS_SC) + cu * (64 * 64);
#pragma unroll
          for (int j = 0; j < 4; ++j) { const int c = mt * 16 + 4 * l4 + j, sA = (2 * ntp) * 16 + l15, sB = sA + 16;
              const bool kA = dir ? (sA >= c) : (sA <= c), kB = dir ? (sB >= c) : (sB <= c);
              const float vA = kA ? a0[j] : 0.f, vB = kB ? a1[j] : 0.f, nA = __shfl_xor(vA, 1), nB = __shfl_xor(vB, 1);
              if (!(l15 & 1)) { *(unsigned*)(SC + c * 64 + sA) = pk2(vA, nA); *(unsigned*)(SC + c * 64 + sB) = pk2(vB, nB); } } }
    }
}

DI void gla_scan_unit(Frame& F, int unit) {
    constexpr int NES = GDV / 64;
    const int es = unit % NES, dir = (unit / NES) & 1, h = (unit / (2 * NES)) % GH, seq = unit / (2 * NES * GH);
    LAS bf16* QDl = (LAS bf16*)(F.lds + RING_OFF);
    LAS bf16* KITl = QDl + 64 * G_LD;
    LAS bf16* VTl = KITl + 256 * G_LDS;
    LAS bf16* SCl = VTl + 64 * G_LDS;
    LAS bf16* STl = SCl + 64 * G_LDS;
    static_assert((64 * G_LD * 2 + 256 * G_LDS + 2 * 64 * G_LDS) * 2 <= RING_BYTES, "gla scan lds");
    const bf16* PROJ = (const bf16*)(F.ws + WS_PROJ);
    const bf16* QD = (const bf16*)(F.ws + WS_QD) + (size_t)dir * T * GQK;
    bf16* O = (bf16*)(F.ws + WS_OF) + (size_t)dir * T * GV;
    const int l15 = F.lane & 15, l4 = F.lane >> 4, w = F.wave;
    __syncthreads();
    for (int i = F.tid; i < 64 * G_LD / 2; i += NTHR) ((LAS unsigned*)STl)[i] = 0u;
    v4f accS[4][2];
#pragma unroll
    for (int a = 0; a < 4; ++a)
#pragma unroll
        for (int b = 0; b < 2; ++b) accS[a][b] = (v4f){0.f, 0.f, 0.f, 0.f};
    v4u pq[4], pk[4], psc, pv; v4f pdec0, pdec1;
#define GLA_FETCH(cc) do { const int n_ = dir ? NCH - 1 - (cc) : (cc), t0_ = seq * SEQ + n_ * GCH; const size_t cu_ = (((size_t)dir * NSEQ + seq) * NCH + n_) * GH + h; \
        _Pragma("unroll") for (int i = 0; i < 4; ++i) { const int q = F.tid + NTHR * i; pq[i] = *(const v4u*)(QD + (size_t)(t0_ + (q >> 5)) * GQK + h * 256 + (q & 31) * 8); \
            pk[i] = *(const v4u*)((const bf16*)(F.ws + WS_KIT) + cu_ * (256 * 64) + q * 8); } \
        psc = *(const v4u*)((const bf16*)(F.ws + WS_SC) + cu_ * (64 * 64) + F.tid * 8); \
        pv = *(const v4u*)(PROJ + (size_t)(t0_ + (F.tid & 63)) * EIN_P + E_V + h * GDV + es * 64 + (F.tid >> 6) * 8); \
        pdec0 = *(const v4f*)((const float*)(F.ws + WS_DEC) + cu_ * 256 + 32 * w + 4 * l4); pdec1 = *(const v4f*)((const float*)(F.ws + WS_DEC) + cu_ * 256 + 32 * w + 16 + 4 * l4); } while (0)
    GLA_FETCH(0);
#pragma unroll 1
    for (int ci = 0; ci < NCH; ++ci) {
        const int n = dir ? NCH - 1 - ci : ci, t0 = seq * SEQ + n * GCH;
#pragma unroll
        for (int i = 0; i < 4; ++i) { const int q = F.tid + NTHR * i;
            *(LAS v4u*)(QDl + (q >> 5) * G_LD + (q & 31) * 8) = pq[i]; *(LAS v4u*)(KITl + (q >> 3) * G_LDS + (q & 7) * 8) = pk[i]; }
        *(LAS v4u*)(SCl + (F.tid >> 3) * G_LDS + (F.tid & 7) * 8) = psc;
        { const int s = F.tid & 63, e8 = F.tid >> 6;
#pragma unroll
          for (int j = 0; j < 4; ++j) { VTl[(e8 * 8 + 2 * j) * G_LDS + s] = (bf16)(pv[j] & 0xffffu); VTl[(e8 * 8 + 2 * j + 1) * G_LDS + s] = (bf16)(pv[j] >> 16); } }
        const v4f dec0 = pdec0, dec1 = pdec1;
        __syncthreads();
        if (ci + 1 < NCH) GLA_FETCH(ci + 1);
        { const int mt = w & 3, ntp = w >> 2; v4f o0 = {0.f, 0.f, 0.f, 0.f}, o1 = o0;
#pragma unroll
          for (int ks = 0; ks < 2; ++ks) { const v8s af = ldfrag(SCl, mt * 16 + l15, G_LDS, ks * 32 + l4 * 8);
              o0 = mma16(af, ldfrag(VTl, (2 * ntp) * 16 + l15, G_LDS, ks * 32 + l4 * 8), o0);
              o1 = mma16(af, ldfrag(VTl, (2 * ntp + 1) * 16 + l15, G_LDS, ks * 32 + l4 * 8), o1); }
#pragma unroll
          for (int ks = 0; ks < 8; ++ks) { const v8s af = ldfrag(QDl, mt * 16 + l15, G_LD, ks * 32 + l4 * 8);
              o0 = mma16(af, ldfrag(STl, (2 * ntp) * 16 + l15, G_LD, ks * 32 + l4 * 8), o0);
              o1 = mma16(af, ldfrag(STl, (2 * ntp + 1) * 16 + l15, G_LD, ks * 32 + l4 * 8), o1); }
#pragma unroll
          for (int j = 0; j < 4; ++j) { bf16* op = O + (size_t)(t0 + mt * 16 + 4 * l4 + j) * GV + h * GDV + es * 64 + (2 * ntp) * 16 + l15;
              const float n0 = __shfl_xor(o0[j], 1), n1 = __shfl_xor(o1[j], 1);
              if (!(l15 & 1)) { *(unsigned*)op = pk2(o0[j], n0); *(unsigned*)(op + 16) = pk2(o1[j], n1); } } }
#pragma unroll
        for (int ks = 0; ks < 2; ++ks) {
            const v8s b0 = ldfrag(KITl, 32 * w + l15, G_LDS, ks * 32 + l4 * 8), b1 = ldfrag(KITl, 32 * w + 16 + l15, G_LDS, ks * 32 + l4 * 8);
#pragma unroll
            for (int et = 0; et < 4; ++et) { const v8s af = ldfrag(VTl, et * 16 + l15, G_LDS, ks * 32 + l4 * 8);
                accS[et][0] = mma16(b0, af, accS[et][0]); accS[et][1] = mma16(b1, af, accS[et][1]); } }
#pragma unroll
        for (int et = 0; et < 4; ++et) { accS[et][0] = accS[et][0] * dec0; accS[et][1] = accS[et][1] * dec1; }
        __syncthreads();
#pragma unroll
        for (int et = 0; et < 4; ++et) {
            *(LAS v2u*)(STl + (et * 16 + l15) * G_LD + 32 * w + 4 * l4) = (v2u){pk2(accS[et][0][0], accS[et][0][1]), pk2(accS[et][0][2], accS[et][0][3])};
            *(LAS v2u*)(STl + (et * 16 + l15) * G_LD + 32 * w + 16 + 4 * l4) = (v2u){pk2(accS[et][1][0], accS[et][1][1]), pk2(accS[et][1][2], accS[et][1][3])}; }
    }
}
DI void gla_post(Frame& F, const float* gn) {
    const bf16* PROJ = (const bf16*)(F.ws + WS_PROJ); bf16* MIX = (bf16*)(F.ws + WS_MIX);
    const bf16* OFp = (const bf16*)(F.ws + WS_OF); const bf16* OBp = OFp + (size_t)T * GV;
    const int gw = F.vcu * NWAVES + F.wave, NGW = F.G * NWAVES;
    const v4f g0 = *(const v4f*)(gn + F.lane * 8), g1 = *(const v4f*)(gn + F.lane * 8 + 4);
    static_assert((T * GH) % 2 == 0, "gla_post pairs");
#pragma unroll 1
    for (int u0 = 2 * gw; u0 < T * GH; u0 += 2 * NGW) {
        v4f o0[2], o1[2]; v4u og[2]; size_t mo[2];
#pragma unroll
        for (int r = 0; r < 2; ++r) { const int u = u0 + r, t = u / GH, h = u % GH; const size_t off = (size_t)t * GV + h * GDV + F.lane * 8;
            const v4u af_ = *(const v4u*)(OFp + off), ab_ = *(const v4u*)(OBp + off);
            const v4f a0 = {bflo(af_.x), bfhi(af_.x), bflo(af_.y), bfhi(af_.y)}, a1 = {bflo(af_.z), bfhi(af_.z), bflo(af_.w), bfhi(af_.w)}, b0 = {bflo(ab_.x), bfhi(ab_.x), bflo(ab_.y), bfhi(ab_.y)}, b1 = {bflo(ab_.z), bfhi(ab_.z), bflo(ab_.w), bfhi(ab_.w)};
            o0[r] = a0 + b0; o1[r] = a1 + b1; og[r] = *(const v4u*)(PROJ + (size_t)t * EIN_P + E_OG + h * GDV + F.lane * 8); mo[r] = (size_t)t * EMIX + h * GDV + F.lane * 8; }
        float ss[2];
#pragma unroll
        for (int r = 0; r < 2; ++r) ss[r] = (o0[r].x * o0[r].x + o0[r].y * o0[r].y) + (o0[r].z * o0[r].z + o0[r].w * o0[r].w) + (o1[r].x * o1[r].x + o1[r].y * o1[r].y) + (o1[r].z * o1[r].z + o1[r].w * o1[r].w);
#pragma unroll
        for (int o = 1; o < 64; o <<= 1) { const float ta = __shfl_xor(ss[0], o), tb = __shfl_xor(ss[1], o); ss[0] += ta; ss[1] += tb; }
#pragma unroll
        for (int r = 0; r < 2; ++r) { const float rr = frsq(ss[r] * (1.0f / GDV) + RMS_EPS); v4u o;
            o.x = pk2(o0[r].x * rr * g0.x * siluf_(bflo(og[r].x)), o0[r].y * rr * g0.y * siluf_(bfhi(og[r].x)));
            o.y = pk2(o0[r].z * rr * g0.z * siluf_(bflo(og[r].y)), o0[r].w * rr * g0.w * siluf_(bfhi(og[r].y)));
            o.z = pk2(o1[r].x * rr * g1.x * siluf_(bflo(og[r].z)), o1[r].y * rr * g1.y * siluf_(bfhi(og[r].z)));
            o.w = pk2(o1[r].z * rr * g1.z * siluf_(bflo(og[r].w)), o1[r].w * rr * g1.w * siluf_(bfhi(og[r].w)));
            *(v4u*)(MIX + mo[r]) = o; }
    }
}

struct EvenW { const float *wg_f, *bg_f, *wg_b, *bg_b, *gnorm, *hcw, *hcb, *w3, *hbias; };
DI void even_mixer_a(Frame& F, const EvenW& W) {
    constexpr int NG1 = NSEQ * NCH * GH, NHF = HW, NH1 = NSEQ * (SEQ / HT) * (HW / 64);
    for (int u = F.vcu; u < NHF; u += F.G) hyena_filter_unit(F, u, W.w3);
    for (int u = F.vcu; u < NG1; u += F.G) gla_prep_unit(F, u, W.wg_f, W.bg_f, W.wg_b, W.bg_b);
    for (int u = F.vcu; u < NH1; u += F.G) hyena_prep_unit(F, u, W.hcw, W.hcb);
}
DI void even_mixer_b(Frame& F, const EvenW& W) {
    constexpr int NG2 = NSEQ * GH * 2 * (GDV / 64), NH2 = HW;
    for (int u = F.vcu; u < NG2; u += F.G) gla_scan_unit(F, u);
    constexpr int H2_SKEW = NPAIR >= 3 ? 5 : 4;
    const int nheavy = NG2 > F.G ? (NG2 - F.G < F.G ? NG2 - F.G : F.G) : 0, nlight = F.G - nheavy;
    for (int s = 0;; ++s) {
        int u;
        if (s < H2_SKEW) { if (F.vcu < nheavy) continue; u = s * nlight + (F.vcu - nheavy); }
        else u = H2_SKEW * nlight + (s - H2_SKEW) * F.G + F.vcu;
        if (u >= NH2) break;
        hyena_conv_unit(F, u, W.hbias);
    }
}
DI void even_mixer_c(Frame& F, const EvenW& W) {
    constexpr int NH3 = NSEQ * (SEQ / HT) * (HW / 64);
    gla_post(F, W.gnorm);
    for (int u = F.vcu; u < NH3; u += F.G) hyena_post_unit(F, u, W.hcw, W.hcb);
}
constexpr int SCH = 64, NSC = SEQ / SCH;
constexpr int NSEG = SEQ / 64;
constexpr size_t WS_XC = WS_SCR,                 SZ_XC = alup((size_t)T * SCD * 2);
constexpr size_t WS_DTV = WS_XC + SZ_XC,         SZ_DTV = alup((size_t)2 * T * SNH * 4);
constexpr size_t WS_ACV = WS_DTV + SZ_DTV,       SZ_ACV = SZ_DTV;
constexpr size_t WS_YS = WS_ACV + SZ_ACV,        SZ_YS = alup((size_t)2 * T * SIN * 4);
constexpr size_t WS_LA = WS_YS + SZ_YS,          SZ_LA = alup((size_t)2 * T * LW * 2);
constexpr size_t WS_LB = WS_LA + SZ_LA,          SZ_LB = SZ_LA;
constexpr size_t WS_SEGA = WS_LB + SZ_LB,        SZ_SEGA = alup((size_t)2 * NSEQ * NSEG * LW * 4);
constexpr size_t WS_SEGH = WS_SEGA + SZ_SEGA,    SZ_SEGH = SZ_SEGA;
constexpr size_t WS_SEGC = WS_SEGH + SZ_SEGH,    SZ_SEGC = SZ_SEGA;
constexpr size_t WS_END_ODD = WS_SEGC + SZ_SEGC;

struct OddW { const float *scw, *scb, *dtb, *alog, *dsk, *snorm, *lcw, *lcb, *wa, *ba, *wx, *bx, *lam; };

DI void lru_pro(Frame& F, const float* wa, const float* wx) {
    bf16* WLT = (bf16*)(F.ws + WS_WLT);
    const int n = 2 * LNB * 2 * 128 * 128;
    for (int i = 2 * (F.vcu * NTHR + F.tid); i < n; i += 2 * F.G * NTHR) {
        const int c = i & 127, d = (i >> 7) & 127, m = (i >> 14) & 1, k = (i >> 15) % LNB, dir = i / (32768 * LNB);
        const float* W = m ? wx : wa;
        *(unsigned*)(WLT + i) = pk2(W[(((size_t)dir * LNB + k) * 128 + c) * 128 + d], W[(((size_t)dir * LNB + k) * 128 + c + 1) * 128 + d]);
    }
}

DI void ssd_prep(Frame& F, const OddW& W) {
    const bf16* PROJ = (const bf16*)(F.ws + WS_PROJ); bf16* XC = (bf16*)(F.ws + WS_XC);
    constexpr int VC = SCD / 8, TB = 16;
    const int gt = F.vcu * NTHR + F.tid, NT = F.G * NTHR, ngrp = NT / VC;
    if (gt < ngrp * VC) {
        const int vc = gt % VC, grp = gt / VC, c0 = vc * 8;
        float w[4][8], bb[8];
#pragma unroll
        for (int e = 0; e < 8; ++e) {
#pragma unroll
            for (int j = 0; j < 4; ++j) w[j][e] = W.scw[(size_t)j * SCD + c0 + e];
            bb[e] = W.scb[c0 + e]; }
        const v4u z4 = {0u, 0u, 0u, 0u};
#pragma unroll 1
        for (int tb = grp; tb < T / TB; tb += ngrp) {
            const int t0 = tb * TB, s0 = t0 % SEQ;
            const bf16* hp = PROJ + (size_t)t0 * OIN_P + O_XBC + c0;
            v4u xm = s0 > 0 ? *(const v4u*)(hp - OIN_P) : z4, x0 = *(const v4u*)hp, x1 = (s0 + 1 < SEQ) ? *(const v4u*)(hp + OIN_P) : z4;
#pragma unroll 8
            for (int i = 0; i < TB; ++i) {
                const v4u x2 = (s0 + i + 2 < SEQ) ? *(const v4u*)(hp + (size_t)(i + 2) * OIN_P) : z4;
                v4u o;
#pragma unroll
                for (int q = 0; q < 4; ++q) {
                    const float a0 = bflo(xm[q]) * w[0][2 * q] + bflo(x0[q]) * w[1][2 * q] + bflo(x1[q]) * w[2][2 * q] + bflo(x2[q]) * w[3][2 * q] + bb[2 * q];
                    const float a1 = bfhi(xm[q]) * w[0][2 * q + 1] + bfhi(x0[q]) * w[1][2 * q + 1] + bfhi(x1[q]) * w[2][2 * q + 1] + bfhi(x2[q]) * w[3][2 * q + 1] + bb[2 * q + 1];
                    o[q] = pk2(siluf_(a0), siluf_(a1)); }
                *(v4u*)(XC + (size_t)(t0 + i) * SCD + c0) = o;
                xm = x0; x0 = x1; x1 = x2;
            }
        }
    }
    float* DTV = (float*)(F.ws + WS_DTV); float* ACV = (float*)(F.ws + WS_ACV);
    constexpr int NU = NSEQ * NSC * 2 * SNH;
#pragma unroll 1
    for (int u = gt; u < NU; u += NT) {
        const int hd = u % SNH, dir = (u / SNH) & 1, n = (u / (2 * SNH)) % NSC, seq = u / (2 * SNH * NSC);
        const float bias = W.dtb[dir * SNH + hd], A = -__expf(W.alog[dir * SNH + hd]);
        const int t0 = seq * SEQ + n * SCH; float acc = 0.f;
#pragma unroll 16
        for (int i = 0; i < SCH; ++i) { const int t = t0 + (dir ? SCH - 1 - i : i);
            const float dt = softplusf_(bf2f(PROJ[(size_t)t * OIN_P + O_DT + dir * SNH + hd]) + bias);
            acc += dt * A;
            DTV[((size_t)dir * T + t) * SNH + hd] = dt; ACV[((size_t)dir * T + t) * SNH + hd] = acc; }
    }
}

constexpr int S_LDN = 136, S_LDS = 72;
DI void ssd_scan_unit(Frame& F, int unit) {
    const int hd = unit % SNH, dir = (unit / SNH) & 1, seq = unit / (2 * SNH), g = hd / SHG;
    LAS bf16* Cl = (LAS bf16*)(F.lds + RING_OFF);
    LAS bf16* Bl = Cl + 64 * S_LDN;
    LAS bf16* BTw = Bl + 64 * S_LDN;
    LAS bf16* XTl = BTw + 128 * S_LDS;
    LAS bf16* Ml = XTl + 64 * S_LDS;
    LAS bf16* STl = Ml + 64 * S_LDS;
    LAS float* acl = (LAS float*)(STl + 64 * S_LDN);
    const bf16* XC = (const bf16*)(F.ws + WS_XC);
    const float* DTV = (const float*)(F.ws + WS_DTV) + (size_t)dir * T * SNH; const float* ACV = (const float*)(F.ws + WS_ACV) + (size_t)dir * T * SNH;
    bf16* Y = (bf16*)(F.ws + WS_YS) + (size_t)dir * T * SIN;
    const int l15 = F.lane & 15, l4 = F.lane >> 4, w = F.wave;
    __syncthreads();
    for (int i = F.tid; i < 64 * S_LDN / 2; i += NTHR) ((LAS unsigned*)STl)[i] = 0u;
    v4f accS[4];
#pragma unroll
    for (int a = 0; a < 4; ++a) accS[a] = (v4f){0.f, 0.f, 0.f, 0.f};
    v4u pc[2], pb[2], px; float pac, pdt, pend;
#define SSD_FETCH(cc) do { const int n_ = dir ? NSC - 1 - (cc) : (cc), t0_ = seq * SEQ + n_ * SCH; const int row = F.tid & 63; \
        _Pragma("unroll") for (int i = 0; i < 2; ++i) { const int c16 = (F.tid >> 6) + 8 * i; \
            pc[i] = *(const v4u*)(XC + (size_t)(t0_ + row) * SCD + SIN + SBC + g * SN + c16 * 8); pb[i] = *(const v4u*)(XC + (size_t)(t0_ + row) * SCD + SIN + g * SN + c16 * 8); } \
        px = *(const v4u*)(XC + (size_t)(t0_ + row) * SCD + hd * SP + (F.tid >> 6) * 8); \
        pac = ACV[(size_t)(t0_ + row) * SNH + hd]; pdt = DTV[(size_t)(t0_ + row) * SNH + hd]; pend = ACV[(size_t)(t0_ + (dir ? 0 : SCH - 1)) * SNH + hd]; } while (0)
    SSD_FETCH(0);
#pragma unroll 1
    for (int ci = 0; ci < NSC; ++ci) {
        const int n = dir ? NSC - 1 - ci : ci, t0 = seq * SEQ + n * SCH;
        const float ac_end = pend;
        { const int row = F.tid & 63; const float ws = __expf(ac_end - pac);
#pragma unroll
          for (int i = 0; i < 2; ++i) { const int c16 = (F.tid >> 6) + 8 * i;
              *(LAS v4u*)(Cl + row * S_LDN + c16 * 8) = pc[i]; *(LAS v4u*)(Bl + row * S_LDN + c16 * 8) = pb[i];
#pragma unroll
              for (int j = 0; j < 4; ++j) { BTw[(c16 * 8 + 2 * j) * S_LDS + row] = (bf16)f2bf(bflo(pb[i][j]) * ws); BTw[(c16 * 8 + 2 * j + 1) * S_LDS + row] = (bf16)f2bf(bfhi(pb[i][j]) * ws); } }
          const int p8 = F.tid >> 6;
#pragma unroll
          for (int j = 0; j < 4; ++j) { XTl[(p8 * 8 + 2 * j) * S_LDS + row] = (bf16)f2bf(bflo(px[j]) * pdt); XTl[(p8 * 8 + 2 * j + 1) * S_LDS + row] = (bf16)f2bf(bfhi(px[j]) * pdt); }
          if (F.tid < 64) acl[row] = pac; }
        __syncthreads();
        if (ci + 1 < NSC) SSD_FETCH(ci + 1);
        const int mt = w & 3, ntp = w >> 2;
        { v4f a0 = {0.f, 0.f, 0.f, 0.f}, a1 = a0;
#pragma unroll
          for (int ks = 0; ks < 4; ++ks) { const v8s bfg = ldfrag(Cl, mt * 16 + l15, S_LDN, ks * 32 + l4 * 8);
              a0 = mma16(ldfrag(Bl, (2 * ntp) * 16 + l15, S_LDN, ks * 32 + l4 * 8), bfg, a0);
              a1 = mma16(ldfrag(Bl, (2 * ntp + 1) * 16 + l15, S_LDN, ks * 32 + l4 * 8), bfg, a1); }
          const int l = mt * 16 + l15, sA = (2 * ntp) * 16 + 4 * l4, sB = sA + 16; const float al = acl[l];
          const v4f acA = *(const LAS v4f*)(acl + sA), acB = *(const LAS v4f*)(acl + sB);
          float mA[4], mB[4];
#pragma unroll
          for (int j = 0; j < 4; ++j) { const bool kA = dir ? (sA + j >= l) : (sA + j <= l), kB = dir ? (sB + j >= l) : (sB + j <= l);
              mA[j] = kA ? a0[j] * __expf(al - acA[j]) : 0.f; mB[j] = kB ? a1[j] * __expf(al - acB[j]) : 0.f; }
          *(LAS v2u*)(Ml + l * S_LDS + sA) = (v2u){pk2(mA[0], mA[1]), pk2(mA[2], mA[3])}; *(LAS v2u*)(Ml + l * S_LDS + sB) = (v2u){pk2(mB[0], mB[1]), pk2(mB[2], mB[3])}; }
        v4f y0 = {0.f, 0.f, 0.f, 0.f}, y1 = y0;
#pragma unroll
        for (int ks = 0; ks < 4; ++ks) { const v8s af = ldfrag(Cl, mt * 16 + l15, S_LDN, ks * 32 + l4 * 8);
            y0 = mma16(af, ldfrag(STl, (2 * ntp) * 16 + l15, S_LDN, ks * 32 + l4 * 8), y0);
            y1 = mma16(af, ldfrag(STl, (2 * ntp + 1) * 16 + l15, S_LDN, ks * 32 + l4 * 8), y1); }
#pragma unroll
        for (int j = 0; j < 4; ++j) { const float sc = __expf(acl[mt * 16 + 4 * l4 + j]); y0[j] *= sc; y1[j] *= sc; }
        __syncthreads();
#pragma unroll
        for (int ks = 0; ks < 2; ++ks) { const v8s af = ldfrag(Ml, mt * 16 + l15, S_LDS, ks * 32 + l4 * 8);
            y0 = mma16(af, ldfrag(XTl, (2 * ntp) * 16 + l15, S_LDS, ks * 32 + l4 * 8), y0);
            y1 = mma16(af, ldfrag(XTl, (2 * ntp + 1) * 16 + l15, S_LDS, ks * 32 + l4 * 8), y1); }
#pragma unroll
        for (int j = 0; j < 4; ++j) { bf16* yp = Y + (size_t)(t0 + mt * 16 + 4 * l4 + j) * SIN + hd * SP + (2 * ntp) * 16 + l15; const float n0 = __shfl_xor(y0[j], 1), n1 = __shfl_xor(y1[j], 1);
            if (!(l15 & 1)) { *(unsigned*)yp = pk2(y0[j], n0); *(unsigned*)(yp + 16) = pk2(y1[j], n1); } }
        { const float dec = __expf(ac_end);
#pragma unroll
          for (int pt = 0; pt < 4; ++pt) accS[pt] = accS[pt] * dec;
#pragma unroll
          for (int ks = 0; ks < 2; ++ks) { const v8s bf = ldfrag(BTw, 16 * w + l15, S_LDS, ks * 32 + l4 * 8);
#pragma unroll
              for (int pt = 0; pt < 4; ++pt) accS[pt] = mma16(bf, ldfrag(XTl, pt * 16 + l15, S_LDS, ks * 32 + l4 * 8), accS[pt]); } }
        __syncthreads();
#pragma unroll
        for (int pt = 0; pt < 4; ++pt) *(LAS v2u*)(STl + (pt * 16 + l15) * S_LDN + 16 * w + 4 * l4) = (v2u){pk2(accS[pt][0], accS[pt][1]), pk2(accS[pt][2], accS[pt][3])};
    }
}
DI void ssd_post(Frame& F, const OddW& W) {
    const bf16* PROJ = (const bf16*)(F.ws + WS_PROJ); const bf16* XC = (const bf16*)(F.ws + WS_XC); bf16* MIX = (bf16*)(F.ws + WS_MIX);
    const bf16* YF = (const bf16*)(F.ws + WS_YS); const bf16* YB = YF + (size_t)T * SIN;
    constexpr int GW = SIN / SG;
    static_assert(GW == 512 && (T * SG) % 2 == 0, "ssd group width, row pairs");
    const int gw = F.vcu * NWAVES + F.wave, NGW = F.G * NWAVES;
#pragma unroll 1
    for (int u0 = 2 * gw; u0 < T * SG; u0 += 2 * NGW) {
        float y[2][8]; float ss[2]; int chs[2]; size_t mo[2];
#pragma unroll
        for (int r = 0; r < 2; ++r) { const int u = u0 + r, t = u / SG, g = u % SG; const int ch = g * GW + F.lane * 8, hd = ch / SP;
            const float ds = W.dsk[hd] + W.dsk[SNH + hd];
            const size_t off = (size_t)t * SIN + ch;
            const v4u af_ = *(const v4u*)(YF + off), ab_ = *(const v4u*)(YB + off);
            const v4f a0 = {bflo(af_.x), bfhi(af_.x), bflo(af_.y), bfhi(af_.y)}, a1 = {bflo(af_.z), bfhi(af_.z), bflo(af_.w), bfhi(af_.w)}, b0 = {bflo(ab_.x), bfhi(ab_.x), bflo(ab_.y), bfhi(ab_.y)}, b1 = {bflo(ab_.z), bfhi(ab_.z), bflo(ab_.w), bfhi(ab_.w)};
            const v4u xs = *(const v4u*)(XC + (size_t)t * SCD + ch), zz = *(const v4u*)(PROJ + (size_t)t * OIN_P + O_Z + ch);
            y[r][0] = (a0.x + b0.x + bflo(xs.x) * ds) * siluf_(bflo(zz.x)); y[r][1] = (a0.y + b0.y + bfhi(xs.x) * ds) * siluf_(bfhi(zz.x));
            y[r][2] = (a0.z + b0.z + bflo(xs.y) * ds) * siluf_(bflo(zz.y)); y[r][3] = (a0.w + b0.w + bfhi(xs.y) * ds) * siluf_(bfhi(zz.y));
            y[r][4] = (a1.x + b1.x + bflo(xs.z) * ds) * siluf_(bflo(zz.z)); y[r][5] = (a1.y + b1.y + bfhi(xs.z) * ds) * siluf_(bfhi(zz.z));
            y[r][6] = (a1.z + b1.z + bflo(xs.w) * ds) * siluf_(bflo(zz.w)); y[r][7] = (a1.w + b1.w + bfhi(xs.w) * ds) * siluf_(bfhi(zz.w));
            float s = 0.f;
#pragma unroll
            for (int e = 0; e < 8; ++e) s += y[r][e] * y[r][e];
            ss[r] = s; chs[r] = ch; mo[r] = (size_t)t * OMIX + ch; }
#pragma unroll
        for (int o = 1; o < 64; o <<= 1) { const float ta = __shfl_xor(ss[0], o), tb = __shfl_xor(ss[1], o); ss[0] += ta; ss[1] += tb; }
#pragma unroll
        for (int r = 0; r < 2; ++r) { const float rr = frsq(ss[r] * (1.0f / GW) + RMS_EPS);
            const v4f g0 = *(const v4f*)(W.snorm + chs[r]), g1 = *(const v4f*)(W.snorm + chs[r] + 4);
            v4u o; o.x = pk2(y[r][0] * rr * g0.x, y[r][1] * rr * g0.y); o.y = pk2(y[r][2] * rr * g0.z, y[r][3] * rr * g0.w); o.z = pk2(y[r][4] * rr * g1.x, y[r][5] * rr * g1.y); o.w = pk2(y[r][6] * rr * g1.z, y[r][7] * rr * g1.w);
            *(v4u*)(MIX + mo[r]) = o; }
    }
}

DI float gelu_tanh(float x) { const float y = 0.7978845608028654f * (x + 0.044715f * x * x * x); const float e = __expf(2.f * y); return 0.5f * x * (2.f - 2.f * frcp(e + 1.f)); }
DI void lru_gate_unit(Frame& F, int unit, const OddW& W) {
    const int k = unit % LNB, seg = (unit / LNB) % NSEG, seq = unit / (LNB * NSEG);
    constexpr int TLD = 72;
    LAS bf16* XCl = (LAS bf16*)(F.lds + RING_OFF);
    LAS bf16* LT = XCl + 64 * S_LDN;
    LAS bf16* rawl = LT;
    LAS float* sub = (LAS float*)(LT + 4 * 128 * TLD);
    static_assert((64 * S_LDN + 4 * 128 * TLD) * 2 + 2 * 4 * 128 * 2 * 4 <= RING_BYTES && 67 * 128 <= 4 * 128 * TLD, "lru lds");
    const bf16* PROJ = (const bf16*)(F.ws + WS_PROJ);
    const int t0 = seq * SEQ + seg * 64, s0 = seg * 64;
    const int l15 = F.lane & 15, l4 = F.lane >> 4, w = F.wave;
    __syncthreads();
    for (int q = F.tid; q < 67 * 16; q += NTHR) { const int row = q >> 4, c8 = q & 15, s = s0 - 1 + row;
        v4u v = {0u, 0u, 0u, 0u};
        if (s >= 0 && s < SEQ) v = *(const v4u*)(PROJ + (size_t)(seq * SEQ + s) * OIN_P + O_R + k * 128 + c8 * 8);
        *(LAS v4u*)(rawl + row * 128 + c8 * 8) = v; }
    __syncthreads();
    {   const int cp = F.tid & 63, tq = F.tid >> 6, c = k * 128 + 2 * cp;
        const v2f w0 = *(const v2f*)(W.lcw + c), w1 = *(const v2f*)(W.lcw + LW + c), w2 = *(const v2f*)(W.lcw + 2 * LW + c), w3 = *(const v2f*)(W.lcw + 3 * LW + c), b = *(const v2f*)(W.lcb + c);
        const LAS unsigned* r32 = (const LAS unsigned*)rawl;
        unsigned xm = r32[(tq * 8) * 64 + cp], x0 = r32[(tq * 8 + 1) * 64 + cp], x1 = r32[(tq * 8 + 2) * 64 + cp];
        unsigned outv[8];
#pragma unroll
        for (int i = 0; i < 8; ++i) { const int tl = tq * 8 + i;
            const unsigned x2 = r32[(tl + 3) * 64 + cp];
            outv[i] = pk2(bflo(xm) * w0.x + bflo(x0) * w1.x + bflo(x1) * w2.x + bflo(x2) * w3.x + b.x, bfhi(xm) * w0.y + bfhi(x0) * w1.y + bfhi(x1) * w2.y + bfhi(x2) * w3.y + b.y);
            xm = x0; x0 = x1; x1 = x2; }
#pragma unroll
        for (int i = 0; i < 8; ++i) ((LAS unsigned*)XCl)[(tq * 8 + i) * (S_LDN / 2) + cp] = outv[i]; }
    __syncthreads();
#pragma unroll 1
    for (int dir = 0; dir < 2; ++dir) {
        const bf16* WA = (const bf16*)(F.ws + WS_WLT) + (((size_t)dir * LNB + k) * 2 + 0) * 16384; const bf16* WX = WA + 16384;
        v4f ar[4], ai[4];
#pragma unroll
        for (int m = 0; m < 4; ++m) { ar[m] = (v4f){0.f, 0.f, 0.f, 0.f}; ai[m] = ar[m]; }
#pragma unroll
        for (int ks = 0; ks < 4; ++ks) { const v8s ba = *(const v8s*)(WA + (16 * w + l15) * 128 + ks * 32 + l4 * 8), bx = *(const v8s*)(WX + (16 * w + l15) * 128 + ks * 32 + l4 * 8);
#pragma unroll
            for (int m = 0; m < 4; ++m) { const v8s af = ldfrag(XCl, m * 16 + l15, S_LDN, ks * 32 + l4 * 8); ar[m] = mma16(af, ba, ar[m]); ai[m] = mma16(af, bx, ai[m]); } }
        const int d = 16 * w + l15, c = k * 128 + d;
        const float bav = W.ba[dir * LW + c], bxv = W.bx[dir * LW + c], sp = softplusf_(-W.lam[dir * LW + c]);
        LAS bf16* LTa = LT + (dir * 2 + 0) * 128 * TLD + d * TLD; LAS bf16* LTb = LT + (dir * 2 + 1) * 128 * TLD + d * TLD;
#pragma unroll
        for (int m = 0; m < 4; ++m) { float la[4], bb[4];
#pragma unroll
            for (int j = 0; j < 4; ++j) { const int tl = m * 16 + 4 * l4 + j;
                const float r = sigmoidf_(ar[m][j] + bav), ii = sigmoidf_(ai[m][j] + bxv);
                la[j] = -8.0f * r * sp; bb[j] = fsqrt_(1.0f - __expf(2.0f * la[j])) * ii * bf2f(XCl[tl * S_LDN + d]); }
            *(LAS v2u*)(LTa + m * 16 + 4 * l4) = (v2u){pk2(la[0], la[1]), pk2(la[2], la[3])}; *(LAS v2u*)(LTb + m * 16 + 4 * l4) = (v2u){pk2(bb[0], bb[1]), pk2(bb[2], bb[3])}; }
    }
    __syncthreads();
#pragma unroll
    for (int i = 0; i < 8; ++i) { const int q = F.tid + NTHR * i, da = q >> 10, dd = (q >> 3) & 127, t8 = (q & 7) * 8, dir = da >> 1, arr = da & 1;
        bf16* G = (bf16*)(F.ws + (arr ? WS_LB : WS_LA)) + ((((size_t)dir * NSEQ + seq) * NSEG + seg) * LW + k * 128) * 64;
        *(v4u*)(G + dd * 64 + t8) = *(const LAS v4u*)(LT + da * 128 * TLD + dd * TLD + t8); }
    {   const int ch = F.tid & 127, q = F.tid >> 7;
#pragma unroll
        for (int dir = 0; dir < 2; ++dir) { const int blk = dir ? 3 - q : q;
            const LAS v4u* pa = (const LAS v4u*)(LT + (dir * 2 + 0) * 128 * TLD + ch * TLD + blk * 16); const LAS v4u* pb = (const LAS v4u*)(LT + (dir * 2 + 1) * 128 * TLD + ch * TLD + blk * 16);
            const v4u a0 = pa[0], a1 = pa[1], b0 = pb[0], b1 = pb[1]; float sa = 0.f, h = 0.f;
#pragma unroll
            for (int i = 0; i < 16; ++i) { const int e = dir ? 15 - i : i; const unsigned wa_ = e < 8 ? a0[e >> 1] : a1[(e - 8) >> 1], wb_ = e < 8 ? b0[e >> 1] : b1[(e - 8) >> 1];
                const float la = (e & 1) ? bfhi(wa_) : bflo(wa_), bb = (e & 1) ? bfhi(wb_) : bflo(wb_); sa += la; h = __expf(la) * h + bb; }
            sub[((dir * 4 + q) * 128 + ch) * 2] = sa; sub[((dir * 4 + q) * 128 + ch) * 2 + 1] = h; } }
    __syncthreads();
    if (F.tid < 256) { const int dir = F.tid >> 7, ch = F.tid & 127; float sa = 0.f, h = 0.f;
#pragma unroll
        for (int q = 0; q < 4; ++q) { const float a = sub[((dir * 4 + q) * 128 + ch) * 2]; h = __expf(a) * h + sub[((dir * 4 + q) * 128 + ch) * 2 + 1]; sa += a; }
        const size_t o = (((size_t)dir * NSEQ + seq) * NSEG + seg) * LW + k * 128 + ch;
        ((float*)(F.ws + WS_SEGA))[o] = __expf(sa); ((float*)(F.ws + WS_SEGH))[o] = h; }
}
DI void lru_carry(Frame& F) {
    const float* SA = (const float*)(F.ws + WS_SEGA); const float* SH = (const float*)(F.ws + WS_SEGH); float* SC = (float*)(F.ws + WS_SEGC);
    constexpr int NU = 2 * NSEQ * LW;
#pragma unroll 1
    for (int u = F.vcu * NTHR + F.tid; u < NU; u += F.G * NTHR) {
        const int ch = u % LW, seq = (u / LW) % NSEQ, dir = u / (LW * NSEQ);
        const size_t o0 = ((size_t)dir * NSEQ + seq) * NSEG * LW + ch; float h = 0.f;
#pragma unroll 8
        for (int jj = 0; jj < NSEG; ++jj) { const int j = dir ? NSEG - 1 - jj : jj; const size_t o = o0 + (size_t)j * LW;
            const float a = SA[o], b = SH[o]; SC[o] = h; h = a * h + b; }
    }
}
DI void lru_out_unit(Frame& F, int unit) {
    constexpr int CGW = LW < NTHR ? LW : NTHR, NCG = LW / CGW, C8 = CGW / 8;
    const int cg = unit % NCG, seg = (unit / NCG) % NSEG, seq = unit / (NCG * NSEG);
    const int t0 = seq * SEQ + seg * 64, c0 = cg * CGW;
    const bf16* PROJ = (const bf16*)(F.ws + WS_PROJ); bf16* MIX = (bf16*)(F.ws + WS_MIX);
    LAS bf16* gt = (LAS bf16*)(F.lds + RING_OFF);
    __syncthreads();
    for (int q = F.tid; q < 64 * C8; q += NTHR) { const int row = q / C8, c8 = q % C8;
        *(LAS v4u*)(gt + row * CGW + c8 * 8) = *(const v4u*)(PROJ + (size_t)(t0 + row) * OIN_P + O_G + c0 + c8 * 8); }
    __syncthreads();
    if (F.tid < CGW) {
        const int ch = c0 + F.tid;
        const float* SH = (const float*)(F.ws + WS_SEGC);
        float hf = SH[(((size_t)0 * NSEQ + seq) * NSEG + seg) * LW + ch], hb = SH[(((size_t)1 * NSEQ + seq) * NSEG + seg) * LW + ch];
        const size_t rf = ((((size_t)0 * NSEQ + seq) * NSEG + seg) * LW + ch) * 64, rb = ((((size_t)1 * NSEQ + seq) * NSEG + seg) * LW + ch) * 64;
        const bf16* LA = (const bf16*)(F.ws + WS_LA); const bf16* LB = (const bf16*)(F.ws + WS_LB);
        float hfs[64];
        { v4u la[8], lb[8];
#pragma unroll
          for (int q = 0; q < 8; ++q) { la[q] = *(const v4u*)(LA + rf + q * 8); lb[q] = *(const v4u*)(LB + rf + q * 8); }
#pragma unroll
          for (int q = 0; q < 8; ++q)
#pragma unroll
              for (int j = 0; j < 4; ++j) { hf = __expf(bflo(la[q][j])) * hf + bflo(lb[q][j]); hfs[q * 8 + 2 * j] = hf; hf = __expf(bfhi(la[q][j])) * hf + bfhi(lb[q][j]); hfs[q * 8 + 2 * j + 1] = hf; } }
        { v4u la[8], lb[8];
#pragma unroll
          for (int q = 0; q < 8; ++q) { la[q] = *(const v4u*)(LA + rb + q * 8); lb[q] = *(const v4u*)(LB + rb + q * 8); }
#pragma unroll
          for (int q = 7; q >= 0; --q)
#pragma unroll
              for (int j = 3; j >= 0; --j) {
                  { const int i = q * 8 + 2 * j + 1; hb = __expf(bfhi(la[q][j])) * hb + bfhi(lb[q][j]);
                    gt[i * CGW + F.tid] = (bf16)f2bf(gelu_tanh(bf2f(gt[i * CGW + F.tid])) * (hfs[i] + hb)); }
                  { const int i = q * 8 + 2 * j; hb = __expf(bflo(la[q][j])) * hb + bflo(lb[q][j]);
                    gt[i * CGW + F.tid] = (bf16)f2bf(gelu_tanh(bf2f(gt[i * CGW + F.tid])) * (hfs[i] + hb)); } } }
    }
    __syncthreads();
    for (int q = F.tid; q < 64 * C8; q += NTHR) { const int row = q / C8, c8 = q % C8;
        *(v4u*)(MIX + (size_t)(t0 + row) * OMIX + SIN + c0 + c8 * 8) = *(const LAS v4u*)(gt + row * CGW + c8 * 8); }
}

DI void odd_mixer_a(Frame& F, const OddW& W) { ssd_prep(F, W); }
DI void odd_mixer_b(Frame& F, const OddW& W) {
    constexpr int NS2 = NSEQ * 2 * SNH, NL1 = NSEQ * NSEG * LNB;
    for (int u = F.vcu; u < NS2; u += F.G) ssd_scan_unit(F, u);
    constexpr int L1_SKEW = 18;
    const int nheavy = NS2 > F.G ? (NS2 - F.G < F.G ? NS2 - F.G : F.G) : 0, nlight = F.G - nheavy;
    for (int s = 0;; ++s) {
        int u;
        if (s < L1_SKEW) { if (F.vcu < nheavy) continue; u = s * nlight + (F.vcu - nheavy); }
        else u = L1_SKEW * nlight + (s - L1_SKEW) * F.G + F.vcu;
        if (u >= NL1) break;
        lru_gate_unit(F, u, W);
    }
}
DI void odd_mixer_c(Frame& F, const OddW& W) { lru_carry(F); ssd_post(F, W); }
DI void odd_mixer_d(Frame& F, const OddW& W) {
    constexpr int NL2 = NSEQ * NSEG * (LW < NTHR ? 1 : LW / NTHR);
    for (int u = F.vcu; u < NL2; u += F.G) lru_out_unit(F, u);
}

constexpr size_t WS_NEED_A = WS_END_FFN > WS_END_EVEN ? WS_END_FFN : WS_END_EVEN;
constexpr size_t WS_NEED = WS_NEED_A > WS_END_ODD ? WS_NEED_A : WS_END_ODD;


struct Args { const float* in[40]; float* out; unsigned char* ws; int ph_lo, ph_hi, li, pad; };
__global__ void __launch_bounds__(NTHR, 2) fwd_kernel(Args args) {
    DECL_DYN_LDS(lds);
    Frame F;
    F.lds = (LAS unsigned char*)lds;
    F.MISC = (volatile LAS unsigned*)(F.lds + MISC_OFF);
    F.tid = threadIdx.x; F.lane = F.tid & 63; F.wave = __builtin_amdgcn_readfirstlane(F.tid >> 6);
    F.G = gridDim.x; { const int bx = blockIdx.x; F.vcu = (F.G % 8 == 0) ? (bx % 8) * (F.G / 8) + bx / 8 : bx; }
    F.out = args.out; F.ws = args.ws;
    F.ctl = (gu32*)(args.ws + WS_CTL);
    for (int u = F.tid; u < (LDS_BYTES - LDSCTL_OFF) / 4; u += NTHR) ((LAS unsigned*)(F.lds + LDSCTL_OFF))[u] = 0u;
    __syncthreads();
    const int lo = args.ph_lo, hi = args.ph_hi;
#ifndef HOST_EMU
    XcdBarrier bar; bar.bar = (unsigned*)(F.ctl + CW_BAR) + args.li * XCD_BAR_WORDS; bar.x = 0; bar.st = nullptr;
    if (hi - lo > 1) bar = xcd_barrier_post((unsigned*)(F.ctl + CW_BAR) + args.li * XCD_BAR_WORDS, F.MISC + 8);
#define GRID_BAR() xcd_barrier(bar)
#else
#define GRID_BAR() do {} while (0)
#endif
#define IN(k) (lo <= (k) && (k) < hi)
#define SEAM(k) do { if (IN(k) && IN((k) + 1)) GRID_BAR(); } while (0)
    bf16* XB = (bf16*)(F.ws + WS_XB); bf16* PROJ = (bf16*)(F.ws + WS_PROJ); bf16* MIX = (bf16*)(F.ws + WS_MIX);
    float* STATS = (float*)(F.ws + WS_STATS);
    bf16* YB = (bf16*)F.out; bf16* Y4 = (bf16*)(F.ws + WS_MIX);
    float* EDGEG = (float*)(F.ws + WS_H); bf16* ACT = (bf16*)(F.ws + WS_ACT);

    const WSrc WS{args.in[2], args.in[16], args.in[17], args.in[31], args.in[34], args.in[37]};
    if (IN(PH_PRO)) { p0_prologue(F, args.in[0], args.in[1], WS); hyena_pro(F, args.in[10], args.in[11], args.in[12], args.in[13]); lru_pro(F, args.in[26], args.in[28]); SEAM(PH_PRO); }

    if (IN(PH_EIN)) {
        pg8::Gemm g{XB, (const bf16*)(F.ws + WS_WEIN), T, EIN_P, DM}; pg8::StaticOrder S; S.init(T, EIN_P, F.G, (int)blockIdx.x);
        pg8::EpiBf16<0> E{PROJ, EIN_P, nullptr, 0, 0, 1.f};
        pg8::gemm_phase<pg8::EpiBf16<0>, pg8::StaticOrder, PG8_ALIGN, PG8_SP2>(F.lds + RING_OFF, g, S, E);
        conv_late_tail(F, WS, (T / 256) * (EIN_P / 256), (int)blockIdx.x, 0, LATE_A);
        SEAM(PH_EIN);
    }
    const EvenW EW{args.in[3], args.in[4], args.in[5], args.in[6], args.in[7], args.in[8], args.in[9], args.in[14], args.in[15]};
    if (IN(PH_EMA)) { even_mixer_a(F, EW); SEAM(PH_EMA); }
    if (IN(PH_EMB)) { even_mixer_b(F, EW); SEAM(PH_EMB); }
    if (IN(PH_EMC)) { even_mixer_c(F, EW); SEAM(PH_EMC); }
    if (IN(PH_EOUT)) {
        pg8::Gemm g{MIX, (const bf16*)(F.ws + WS_WEOUT), T, DM, EMIX}; pg8::StaticOrder S; S.init(T, DM, F.G, (int)blockIdx.x);
        pg8::EpiResBf<true> E{args.in[0], args.in[1], NSEQ_P * SEQ, YB, DM, DN_ALPHA, nullptr, nullptr, nullptr};
        pg8::gemm_phase<pg8::EpiResBf<true>, pg8::StaticOrder, PG8_ALIGN, PG8_SP2>(F.lds + RING_OFF, g, S, E);
        SEAM(PH_EOUT);
    }
    if (IN(PH_LN1A)) { ln_phase<false>(F, YB, nullptr, XB, STATS, args.in[32], args.in[33]); SEAM(PH_LN1A); }
    if (IN(PH_UP0)) {
        pg8::Gemm g{XB, (const bf16*)(F.ws + WS_WUP), T, FF2, DM}; pg8::StaticOrder S; S.init(T, FF2, F.G, (int)blockIdx.x);
        pg8::EpiConvGate E{ACT, FF, args.in[35], args.in[36], EDGEG, (LAS float*)(F.lds + EDGE_OFF)};
        pg8::gemm_phase<pg8::EpiConvGate, pg8::StaticOrder, PG8_ALIGN, PG8_SP2>(F.lds + RING_OFF, g, S, E);
        conv_late_tail(F, WS, (T / 256) * (FF2 / 256), (int)blockIdx.x, LATE_A, LATE_A + LATE_B);
        SEAM(PH_UP0);
    }
    if (IN(PH_CG0)) { convgate_fix_phase(F, EDGEG, ACT, args.in[35], args.in[36]); SEAM(PH_CG0); }
    if (IN(PH_DN0)) {
        pg8::Gemm g{ACT, (const bf16*)(F.ws + WS_WDN), T, DM, FF}; pg8::StaticOrder S; S.init(T, DM, F.G, (int)blockIdx.x);
        pg8::EpiResBf<false> E{YB, nullptr, 0, YB, DM, DN_ALPHA, STATS, args.in[32], args.in[33]};
        pg8::gemm_phase<pg8::EpiResBf<false>, pg8::StaticOrder, PG8_ALIGN, PG8_SP2>(F.lds + RING_OFF, g, S, E);
        SEAM(PH_DN0);
    }
    if (IN(PH_LN2A)) { ln_phase<false>(F, YB, nullptr, XB, STATS, args.in[38], args.in[39]); SEAM(PH_LN2A); }

    if (IN(PH_OIN)) {
        pg8::Gemm g{XB, (const bf16*)(F.ws + WS_WOIN), T, OIN_P, DM}; pg8::StaticOrder S; S.init(T, OIN_P, F.G, (int)blockIdx.x);
        pg8::EpiBf16<0> E{PROJ, OIN_P, nullptr, 0, 0, 1.f};
        pg8::gemm_phase<pg8::EpiBf16<0>, pg8::StaticOrder, PG8_ALIGN, PG8_SP2>(F.lds + RING_OFF, g, S, E);
        SEAM(PH_OIN);
    }
    const OddW OW{args.in[18], args.in[19], args.in[20], args.in[21], args.in[22], args.in[23], args.in[24], args.in[25], args.in[26], args.in[27], args.in[28], args.in[29], args.in[30]};
    if (IN(PH_OMA)) { odd_mixer_a(F, OW); SEAM(PH_OMA); }
    if (IN(PH_OMB)) { odd_mixer_b(F, OW); SEAM(PH_OMB); }
    if (IN(PH_OMC)) { odd_mixer_c(F, OW); SEAM(PH_OMC); }
    if (IN(PH_OMD)) { odd_mixer_d(F, OW); SEAM(PH_OMD); }
    if (IN(PH_OOUT)) {
        pg8::Gemm g{MIX, (const bf16*)(F.ws + WS_WOOUT), T, DM, OMIX}; pg8::StaticOrder S; S.init(T, DM, F.G, (int)blockIdx.x);
        pg8::EpiResBf<false> E{YB, nullptr, 0, YB, DM, DN_ALPHA, STATS, args.in[38], args.in[39]};
        pg8::gemm_phase<pg8::EpiResBf<false>, pg8::StaticOrder, PG8_ALIGN, PG8_SP2>(F.lds + RING_OFF, g, S, E);
        SEAM(PH_OOUT);
    }
    if (IN(PH_LN1B)) { ln_phase<false>(F, YB, nullptr, XB, STATS, args.in[32] + DM, args.in[33] + DM); SEAM(PH_LN1B); }
    if (IN(PH_UP1)) {
        pg8::Gemm g{XB, (const bf16*)(F.ws + WS_WUP + SZ_WUP1), T, FF2, DM}; pg8::StaticOrder S; S.init(T, FF2, F.G, (int)blockIdx.x);
        pg8::EpiConvGate E{ACT, FF, args.in[35] + (size_t)3 * FF2, args.in[36] + FF2, EDGEG, (LAS float*)(F.lds + EDGE_OFF)};
        pg8::gemm_phase<pg8::EpiConvGate, pg8::StaticOrder, PG8_ALIGN, PG8_SP2>(F.lds + RING_OFF, g, S, E);
        SEAM(PH_UP1);
    }
    if (IN(PH_CG1)) { convgate_fix_phase(F, EDGEG, ACT, args.in[35] + (size_t)3 * FF2, args.in[36] + FF2); SEAM(PH_CG1); }
    if (IN(PH_DN1)) {
        pg8::Gemm g{ACT, (const bf16*)(F.ws + WS_WDN + SZ_WDN1), T, DM, FF}; pg8::StaticOrder S; S.init(T, DM, F.G, (int)blockIdx.x);
        pg8::EpiResBf<false> E{YB, nullptr, 0, Y4, DM, DN_ALPHA, STATS, args.in[32] + DM, args.in[33] + DM};
        pg8::gemm_phase<pg8::EpiResBf<false>, pg8::StaticOrder, PG8_ALIGN, PG8_SP2>(F.lds + RING_OFF, g, S, E);
        SEAM(PH_DN1);
    }
    if (IN(PH_LN2B)) { ln_phase<true>(F, Y4, F.out, nullptr, STATS, args.in[38] + DM, args.in[39] + DM); }
#undef IN
#undef SEAM
}

#ifndef HOST_EMU
extern "C" void kernel_launch(void* const* d_in, const int* in_sizes, int n_in, void* d_out, int out_size, void* d_ws, size_t ws_size, hipStream_t stream) {
    static int grid = 0;
    if (grid == 0) {
        if (n_in != 40 || out_size != T * DM || ws_size < WS_NEED) { fprintf(stderr, "kernel_launch: shape mismatch n_in %d out %d ws %zu (need %zu)\n", n_in, out_size, ws_size, (size_t)WS_NEED); grid = -1; return; }
        int dev = 0, cus = 0, per_cu = 0;
        if (hipGetDevice(&dev) != hipSuccess || hipDeviceGetAttribute(&cus, hipDeviceAttributeMultiprocessorCount, dev) != hipSuccess) { grid = -1; return; }
        if (hipFuncSetAttribute((const void*)fwd_kernel, hipFuncAttributeMaxDynamicSharedMemorySize, LDS_BYTES) != hipSuccess) { fprintf(stderr, "kernel_launch: hipFuncSetAttribute failed\n"); grid = -1; return; }
        if (hipOccupancyMaxActiveBlocksPerMultiprocessor(&per_cu, (const void*)fwd_kernel, NTHR, LDS_BYTES) != hipSuccess || per_cu < 1) fprintf(stderr, "kernel_launch: occupancy query says %d\n", per_cu);
        (void)hipGetLastError();
        grid = cus;
    }
    if (grid < 0) return;
    if (hipMemsetAsync((char*)d_ws + WS_CTL, 0, CTL_ZERO_BYTES, stream) != hipSuccess) return;
    Args a{};
    for (int i = 0; i < 40; ++i) a.in[i] = (const float*)d_in[i];
    a.out = (float*)d_out; a.ws = (unsigned char*)d_ws;
#if defined(PROBE_RERUN_LO)
    a.ph_lo = 0; a.ph_hi = PROBE_RERUN_HI + 1; a.li = 0;
    hipLaunchKernelGGL(fwd_kernel, dim3(grid), dim3(NTHR), LDS_BYTES, stream, a);
    a.ph_lo = PROBE_RERUN_LO; a.ph_hi = NPH; a.li = 1;
    hipLaunchKernelGGL(fwd_kernel, dim3(grid), dim3(NTHR), LDS_BYTES, stream, a);
#elif MK_ONE_LAUNCH
    a.ph_lo = 0; a.ph_hi = NPH;
    hipLaunchKernelGGL(fwd_kernel, dim3(grid), dim3(NTHR), LDS_BYTES, stream, a);
#else
    for (int p = 0; p < NPH; ++p) { a.ph_lo = p; a.ph_hi = p + 1; hipLaunchKernelGGL(fwd_kernel, dim3(grid), dim3(NTHR), LDS_BYTES, stream, a); }
#endif
}
#endif
```

```cpp
#ifndef HOST_EMU
#include <hip/hip_runtime.h>
#endif
#include <cstdio>
#include <cstdint>

#ifndef SMALL_CFG
constexpr int DM = 4096, SEQ = 4096, NSEQ_P = 2, NSEQ_S = 4;
constexpr int GH = 4;
constexpr int HW = 2048;
constexpr int SG = 4, SHG = 8;
constexpr int LNB = 16;
constexpr int FF = 11008;
constexpr int NLAYER = 2;
#else
#ifndef CFG_SEQ
#define CFG_SEQ 256
#endif
#ifndef CFG_GH
#define CFG_GH 1
#endif
#ifndef CFG_NP
#define CFG_NP 1
#endif
#ifndef CFG_NS
#define CFG_NS 1
#endif
constexpr int DM = 256, SEQ = CFG_SEQ, NSEQ_P = CFG_NP, NSEQ_S = CFG_NS;
constexpr int GH = CFG_GH;
constexpr int HW = 128;
constexpr int SG = 2, SHG = 8;
constexpr int LNB = 2;
constexpr int FF = 256;
constexpr int NLAYER = 2;
#endif
constexpr int NSEQ = NSEQ_P + NSEQ_S, T = NSEQ * SEQ;
constexpr int GDK = 256, GDV = 512, GQK = GH * GDK, GV = GH * GDV, GR = 16, GCH = 64;
constexpr int HEMB = 33, HFH = 64, HBANDS = 16;
constexpr int EIN = 2 * GQK + 2 * GV + 2 * GR + 3 * HW;
constexpr int EIN_P = (EIN + 255) / 256 * 256;
constexpr int EMIX = GV + HW;
constexpr int E_Q = 0, E_K = GQK, E_V = 2 * GQK, E_OG = 2 * GQK + GV, E_LRF = 2 * GQK + 2 * GV, E_LRB = E_LRF + GR, E_HY = E_LRB + GR;
constexpr int SNH = SG * SHG, SP = 64, SN = 128, SIN = SNH * SP, SBC = SG * SN, SCD = SIN + 2 * SBC;
constexpr int LW = LNB * 128;
constexpr int OIN = SIN + SCD + 2 * SNH + 2 * LW;
constexpr int OIN_P = (OIN + 255) / 256 * 256;
constexpr int OMIX = SIN + LW;
constexpr int O_Z = 0, O_XBC = SIN, O_DT = SIN + SCD, O_G = O_DT + 2 * SNH, O_R = O_G + LW;
constexpr int FF2 = 2 * FF;
constexpr float LN_EPS = 1e-5f, RMS_EPS = 1e-6f;
constexpr float DN_ALPHA = 1.4142135623730951f;
static_assert(EIN % 32 == 0 && OIN % 32 == 0 && FF2 % 32 == 0 && DM % 64 == 0 && FF % 64 == 0 && EMIX % 64 == 0 && OMIX % 64 == 0, "prologue transposition items");
static_assert(T % 256 == 0 && FF2 % 256 == 0 && DM % 256 == 0 && (NSEQ_P * SEQ) % 256 == 0, "GEMM tiles");

#ifndef HOST_EMU
#define GAS __attribute__((address_space(1)))
#define LAS __attribute__((address_space(3)))
#else
#define GAS
#define LAS
#endif
typedef unsigned short bf16;
typedef unsigned v4u __attribute__((ext_vector_type(4)));
typedef unsigned v2u __attribute__((ext_vector_type(2)));
typedef float v4f __attribute__((ext_vector_type(4)));
typedef float v2f __attribute__((ext_vector_type(2)));
typedef short v8s __attribute__((ext_vector_type(8)));
#define DI __device__ __forceinline__
#ifndef HOST_EMU
DI unsigned pk2(float lo, float hi) { unsigned r; asm("v_cvt_pk_bf16_f32 %0, %1, %2" : "=v"(r) : "v"(lo), "v"(hi)); return r; }
DI unsigned f2bf(float f) { return pk2(f, 0.f) & 0xffffu; }
DI float frcp(float x) { return __builtin_amdgcn_rcpf(x); }
DI float frsq(float x) { return __builtin_amdgcn_rsqf(x); }
DI float fsqrt_(float x) { return __builtin_amdgcn_sqrtf(x); }
DI float lane_xor1(float x) { return __builtin_bit_cast(float, __builtin_amdgcn_update_dpp(0, __builtin_bit_cast(int, x), 0xB1, 0xf, 0xf, true)); }
#else
DI unsigned f2bf(float f) { unsigned u = __builtin_bit_cast(unsigned, f); return (u + 0x7fffu + ((u >> 16) & 1u)) >> 16; }
DI unsigned pk2(float lo, float hi) { return f2bf(lo) | (f2bf(hi) << 16); }
DI float frcp(float x) { return 1.f / x; }
DI float frsq(float x) { return 1.f / sqrtf(x); }
DI float fsqrt_(float x) { return sqrtf(x); }
DI float lane_xor1(float x) { return __shfl_xor(x, 1); }
#endif
DI float bf2f(unsigned b) { return __builtin_bit_cast(float, b << 16); }
DI float bflo(unsigned w) { return __builtin_bit_cast(float, w << 16); }
DI float bfhi(unsigned w) { return __builtin_bit_cast(float, w & 0xffff0000u); }
DI float sigmoidf_(float x) { return frcp(1.f + __expf(-x)); }
DI float siluf_(float x) { return x * frcp(1.f + __expf(-x)); }
DI float softplusf_(float x) { return (x > 0.f ? x : 0.f) + log1pf(__expf(-fabsf(x))); }
#ifndef HOST_EMU
#define WAVE_SYNC() asm volatile("s_waitcnt lgkmcnt(0)" ::: "memory")
#define LDS_WAIT() asm volatile("s_waitcnt lgkmcnt(0)" ::: "memory")
#define VM_WAIT() asm volatile("s_waitcnt vmcnt(0)" ::: "memory")
#define CFENCE() asm volatile("" ::: "memory")
#else
#define CFENCE() do {} while (0)
#endif

#ifndef HOST_EMU
#define DECL_DYN_LDS(name) extern __shared__ __attribute__((aligned(16))) unsigned char name[]
#endif
namespace pg8 {
#ifndef HOST_EMU
#define PG8_LAS __attribute__((address_space(3)))
#else
#define PG8_LAS
#endif
typedef unsigned short bf16_t;
typedef short bf16x8 __attribute__((ext_vector_type(8)));
typedef float f32x4 __attribute__((ext_vector_type(4)));
typedef unsigned u32x4 __attribute__((ext_vector_type(4)));
constexpr int BM = 256, BK = 64, HALF = 128, HTB = HALF * BK * 2  , STAGE_BYTES = 8 * HTB, NXCD = 8, WGM = 4;

__host__ __device__ __forceinline__ int lds_byte(int r, int c) { const int st = (r >> 4) * 2 + (c >> 5), rr = r & 15, cc = c & 31, ob = rr * 64 + cc * 2; return st * 1024 + (ob ^ (((ob >> 9) & 1) << 5)); }
__host__ __device__ __forceinline__ void stage_rc(int b, int& R, int& C) { const int st = b / 1024, sb = b % 1024, swz = sb ^ (((sb >> 9) & 1) << 5); R = (st >> 1) * 16 + swz / 64; C = (st & 1) * 32 + (swz % 64) / 2; }
__host__ __device__ __forceinline__ int perm32(int rho) { const int n = rho >> 4, i = rho & 15; return 8 * (i >> 2) + 4 * n + (i & 3); }

struct Unit { int pm, pn; };
struct Gemm { const bf16_t* A; const bf16_t* Bt; int M, N, K; };

struct StaticOrder {
    int nM, nN, nwg, G, c;
    __host__ __device__ void init(int M, int N, int G_, int c_) { nM = M / BM; nN = N / BM; nwg = nM * nN; G = G_; c = c_; }
    __host__ __device__ bool next(int i, Unit& u) const {
        const long L = (long)i * G + c; if (L >= nwg) return false;
        int wgid = (int)L; { const int q = nwg / NXCD, r = nwg % NXCD, xcd = wgid % NXCD, off = wgid / NXCD; wgid = (xcd < r ? xcd * (q + 1) : r * (q + 1) + (xcd - r) * q) + off; }
        const int nig = WGM * nN, gid = wgid / nig, fm = gid * WGM, gsz = (nM - fm) < WGM ? (nM - fm) : WGM;
        u.pm = fm + ((wgid % nig) % gsz); u.pn = (wgid % nig) / gsz; return true;
    }
    __device__ __forceinline__ void a_ready(const Unit&) const {}
    __device__ __forceinline__ void done(const Unit&) const {}
};

#ifndef HOST_EMU
__device__ __forceinline__ unsigned cvt_pk_bf16(float lo, float hi) { unsigned r; asm volatile("v_cvt_pk_bf16_f32 %0, %1, %2" : "=v"(r) : "v"(lo), "v"(hi)); return r; }
#else
__device__ __forceinline__ unsigned cvt_pk_bf16(float lo, float hi) { return pk2(lo, hi); }
#endif
typedef float f32x2 __attribute__((ext_vector_type(2)));
__device__ __forceinline__ f32x2 gelu_pk(f32x2 v) {
    const f32x2 av = __builtin_elementwise_abs(v), d = av * 0.2316418882f + 1.0f;
#ifndef HOST_EMU
    f32x2 t; t.x = __builtin_amdgcn_rcpf(d.x); t.y = __builtin_amdgcn_rcpf(d.y);
#else
    f32x2 t; t.x = 1.f / d.x; t.y = 1.f / d.y;
#endif
    f32x2 q = t * 0.5307027145f + (-0.7265760135f); q = q * t + 0.7107068705f; q = q * t + (-0.142248368f); q = q * t + 0.127414796f; q = q * t;
    const f32x2 s = (v * v) * (-0.72134752044f);
#ifndef HOST_EMU
    f32x2 e; e.x = __builtin_amdgcn_exp2f(s.x); e.y = __builtin_amdgcn_exp2f(s.y);
#else
    f32x2 e; e.x = exp2f(s.x); e.y = exp2f(s.y);
#endif
    const f32x2 m = v * (q * e), r = v - m;
    f32x2 o; o.x = v.x < 0.f ? m.x : r.x; o.y = v.y < 0.f ? m.y : r.y; return o;
}

template <int ACT  > struct EpiBf16 {
    static constexpr bool PERM = true, AFTER_DRAIN = false; static_assert(ACT == 0 || ACT == 1, "EpiBf16: ACT is 0 (none) or 1 (gelu_pk)");
    bf16_t* O; int ldc; const float* bias; int split_cols; size_t split_stride; float scale0;
    __device__ __forceinline__ void operator()(const f32x4 (&acc)[2][2][4][2], const Unit& u, int wr, int wc, int fr, int fq) const {
        const int row0 = u.pm * BM + wr * 64 + fr; int colt = u.pn * BM; bf16_t* base = O;
        float sc = 1.f; if (split_cols) { const int t = colt / split_cols; base += (size_t)t * split_stride; colt -= t * split_cols; if (t == 0) sc = scale0; }
        const int col0 = colt + wc * 32 + 8 * fq, bcol0 = u.pn * BM + wc * 32 + 8 * fq;
        f32x4 bv[2][2];
#pragma unroll
        for (int bj = 0; bj < 2; ++bj)
#pragma unroll
            for (int n = 0; n < 2; ++n) bv[bj][n] = bias ? *(const f32x4*)(bias + bcol0 + bj * HALF + 4 * n) : (f32x4){0.f, 0.f, 0.f, 0.f};
#pragma unroll
        for (int ai = 0; ai < 2; ++ai)
#pragma unroll
            for (int m = 0; m < 4; ++m) { bf16_t* rowp = base + (size_t)(row0 + ai * HALF + m * 16) * ldc + col0;
#pragma unroll
                for (int bj = 0; bj < 2; ++bj) { f32x4 v0 = acc[ai][bj][m][0] + bv[bj][0], v1 = acc[ai][bj][m][1] + bv[bj][1];
                    if (ACT == 1) { f32x2 a = gelu_pk((f32x2){v0[0], v0[1]}), b = gelu_pk((f32x2){v0[2], v0[3]}), c = gelu_pk((f32x2){v1[0], v1[1]}), d = gelu_pk((f32x2){v1[2], v1[3]});
                        v0 = (f32x4){a.x, a.y, b.x, b.y}; v1 = (f32x4){c.x, c.y, d.x, d.y}; }
                    v0 = v0 * sc; v1 = v1 * sc; u32x4 w; w.x = cvt_pk_bf16(v0[0], v0[1]); w.y = cvt_pk_bf16(v0[2], v0[3]); w.z = cvt_pk_bf16(v1[0], v1[1]); w.w = cvt_pk_bf16(v1[2], v1[3]);
                    *(u32x4*)(rowp + bj * HALF) = w; } }
    }
};
struct EpiResF32 {
    static constexpr bool PERM = false, AFTER_DRAIN = false;
    const float* res; float* out; int ldc; float alpha;
    const float* stats; const float* lg; const float* lb;
    const float* res2; int split;
    __device__ __forceinline__ void operator()(const f32x4 (&acc)[2][2][4][2], const Unit& u, int wr, int wc, int fr, int fq) const {
        const int row0 = u.pm * BM + wr * 64 + fr, col0 = u.pn * BM + wc * 32 + 4 * fq;
        const float* rbase = (res2 && u.pm * BM >= split) ? res2 - (size_t)split * ldc : res;
        f32x4 gv[2][2], bv[2][2];
        if (stats) {
#pragma unroll
            for (int bj = 0; bj < 2; ++bj)
#pragma unroll
                for (int n = 0; n < 2; ++n) { gv[bj][n] = *(const f32x4*)(lg + col0 + bj * HALF + n * 16); bv[bj][n] = *(const f32x4*)(lb + col0 + bj * HALF + n * 16); } }
#pragma unroll
        for (int ai = 0; ai < 2; ++ai)
#pragma unroll
            for (int m = 0; m < 4; ++m) { const int row = row0 + ai * HALF + m * 16; const size_t off = (size_t)row * ldc + col0;
                f32x4 rv[2][2];
#pragma unroll
                for (int bj = 0; bj < 2; ++bj)
#pragma unroll
                    for (int n = 0; n < 2; ++n) rv[bj][n] = *(const f32x4*)(rbase + off + bj * HALF + n * 16);
                if (stats) { const float mu = stats[2 * row], rs = stats[2 * row + 1];
#pragma unroll
                    for (int bj = 0; bj < 2; ++bj)
#pragma unroll
                        for (int n = 0; n < 2; ++n) rv[bj][n] = (rv[bj][n] - mu) * rs * gv[bj][n] + bv[bj][n]; }
#pragma unroll
                for (int bj = 0; bj < 2; ++bj)
#pragma unroll
                    for (int n = 0; n < 2; ++n) *(f32x4*)(out + off + bj * HALF + n * 16) = rv[bj][n] * alpha + acc[ai][bj][m][n]; }
    }
};

template <bool RES_F32> struct EpiResBf {
    static constexpr bool PERM = true, AFTER_DRAIN = false;
    const void* res; const float* res2; int split;
    bf16_t* out; int ldc; float alpha;
    const float* stats; const float* lg; const float* lb;
    __device__ __forceinline__ void operator()(const f32x4 (&acc)[2][2][4][2], const Unit& u, int wr, int wc, int fr, int fq) const {
        const int row0 = u.pm * BM + wr * 64 + fr, col8 = u.pn * BM + wc * 32 + 8 * fq;
        f32x4 gv[2][2], bv[2][2];
        if (stats) {
#pragma unroll
            for (int bj = 0; bj < 2; ++bj)
#pragma unroll
                for (int n = 0; n < 2; ++n) { gv[bj][n] = *(const f32x4*)(lg + col8 + bj * HALF + 4 * n); bv[bj][n] = *(const f32x4*)(lb + col8 + bj * HALF + 4 * n); } }
#pragma unroll
        for (int ai = 0; ai < 2; ++ai)
#pragma unroll
            for (int m = 0; m < 4; ++m) { const int row = row0 + ai * HALF + m * 16; const size_t off = (size_t)row * ldc + col8;
                f32x4 rv[2][2];
                if constexpr (RES_F32) { const float* rb_ = (res2 && u.pm * BM >= split) ? res2 - (size_t)split * ldc : (const float*)res;
#pragma unroll
                    for (int bj = 0; bj < 2; ++bj)
#pragma unroll
                        for (int n = 0; n < 2; ++n) rv[bj][n] = *(const f32x4*)(rb_ + off + bj * HALF + 4 * n);
                } else {
#pragma unroll
                    for (int bj = 0; bj < 2; ++bj) { const u32x4 w = *(const u32x4*)((const bf16_t*)res + off + bj * HALF);
                        rv[bj][0] = (f32x4){bflo(w.x), bfhi(w.x), bflo(w.y), bfhi(w.y)}; rv[bj][1] = (f32x4){bflo(w.z), bfhi(w.z), bflo(w.w), bfhi(w.w)}; } }
                if (stats) { const float mu = stats[2 * row], rs = stats[2 * row + 1];
#pragma unroll
                    for (int bj = 0; bj < 2; ++bj)
#pragma unroll
                        for (int n = 0; n < 2; ++n) rv[bj][n] = (rv[bj][n] - mu) * rs * gv[bj][n] + bv[bj][n]; }
#pragma unroll
                for (int bj = 0; bj < 2; ++bj) { const f32x4 y0 = rv[bj][0] * alpha + acc[ai][bj][m][0], y1 = rv[bj][1] * alpha + acc[ai][bj][m][1];
                    u32x4 w; w.x = cvt_pk_bf16(y0[0], y0[1]); w.y = cvt_pk_bf16(y0[2], y0[3]); w.z = cvt_pk_bf16(y1[0], y1[1]); w.w = cvt_pk_bf16(y1[2], y1[3]);
                    *(u32x4*)(out + off + bj * HALF) = w; } }
    }
};

#ifndef HOST_EMU
__device__ __forceinline__ float rot_r16(float x) { return __builtin_bit_cast(float, __builtin_amdgcn_update_dpp(0, __builtin_bit_cast(int, x), 0x121, 0xf, 0xf, false)); }
__device__ __forceinline__ float rot_l16(float x) { return __builtin_bit_cast(float, __builtin_amdgcn_update_dpp(0, __builtin_bit_cast(int, x), 0x12F, 0xf, 0xf, false)); }
#else
__device__ __forceinline__ float rot_r16(float x) { const int l = threadIdx.x & 63; return __shfl(x, (l & ~15) | ((l - 1) & 15)); }
__device__ __forceinline__ float rot_l16(float x) { const int l = threadIdx.x & 63; return __shfl(x, (l & ~15) | ((l + 1) & 15)); }
#endif
struct EpiConvGate {
    static constexpr bool PERM = true, AFTER_DRAIN = false;
    bf16_t* ACT; int ff;
    const float* cw; const float* cb;
    float* edgeg;
    PG8_LAS float* edge;
    __device__ __forceinline__ void operator()(const f32x4 (&acc)[2][2][4][2], const Unit& u, int wr, int wc, int fr, int fq) const {
        const int lc = wc * 32 + 8 * fq;
        const int ch0 = u.pn * HALF + lc;
        const int nN = 2 * ff / BM;
#pragma unroll
        for (int ai = 0; ai < 2; ++ai) { const int bi = 2 * ai + wr;
#pragma unroll
            for (int bj = 0; bj < 2; ++bj)
#pragma unroll
                for (int n = 0; n < 2; ++n) {
                    if (fr == 0) *(PG8_LAS f32x4*)(edge + (bi * 2 + 0) * BM + bj * HALF + lc + 4 * n) = acc[ai][bj][0][n];
                    if (fr == 15) *(PG8_LAS f32x4*)(edge + (bi * 2 + 1) * BM + bj * HALF + lc + 4 * n) = acc[ai][bj][3][n];
                    if (bi == 0 && fr < 2) *(f32x4*)(edgeg + (((size_t)u.pm * 4 + fr) * nN + u.pn) * BM + bj * HALF + lc + 4 * n) = acc[ai][bj][0][n];
                    if (bi == 3 && fr >= 14) *(f32x4*)(edgeg + (((size_t)u.pm * 4 + (fr - 12)) * nN + u.pn) * BM + bj * HALF + lc + 4 * n) = acc[ai][bj][3][n];
                } }
#ifndef HOST_EMU
        asm volatile("s_waitcnt lgkmcnt(0)" ::: "memory"); __builtin_amdgcn_s_barrier(); asm volatile("" ::: "memory");
#else
        __syncthreads();
#endif
        typedef unsigned u32x2_ __attribute__((ext_vector_type(2)));
        u32x2_ keep[2][4];
#pragma unroll
        for (int n = 0; n < 2; ++n) {
            f32x4 wg[3], wu[3], bg, bu;
#pragma unroll
            for (int j = 0; j < 3; ++j) { wg[j] = *(const f32x4*)(cw + (size_t)j * 2 * ff + ch0 + 4 * n); wu[j] = *(const f32x4*)(cw + (size_t)j * 2 * ff + ff + ch0 + 4 * n); }
            bg = *(const f32x4*)(cb + ch0 + 4 * n); bu = *(const f32x4*)(cb + ff + ch0 + 4 * n);
#pragma unroll
            for (int ai = 0; ai < 2; ++ai) { const int bi = 2 * ai + wr;
#pragma unroll
                for (int m = 0; m < 4; ++m) {
                    f32x4 cv[2];
#pragma unroll
                    for (int bj = 0; bj < 2; ++bj) {
                        const f32x4 x = acc[ai][bj][m][n]; f32x4 up, dn, pu, nd;
#pragma unroll
                        for (int i = 0; i < 4; ++i) { up[i] = rot_r16(x[i]); dn[i] = rot_l16(x[i]); }
                        if (m > 0) {
#pragma unroll
                            for (int i = 0; i < 4; ++i) pu[i] = rot_r16(acc[ai][bj][m > 0 ? m - 1 : 0][n][i]);
                        } else pu = (bi > 0) ? *(const PG8_LAS f32x4*)(edge + ((bi - 1) * 2 + 1) * BM + bj * HALF + lc + 4 * n) : (f32x4){0.f, 0.f, 0.f, 0.f};
                        if (m < 3) {
#pragma unroll
                            for (int i = 0; i < 4; ++i) nd[i] = rot_l16(acc[ai][bj][m < 3 ? m + 1 : 3][n][i]);
                        } else nd = (bi < 3) ? *(const PG8_LAS f32x4*)(edge + ((bi + 1) * 2 + 0) * BM + bj * HALF + lc + 4 * n) : (f32x4){0.f, 0.f, 0.f, 0.f};
                        if (fr == 0) up = pu;
                        if (fr == 15) dn = nd;
                        cv[bj] = bj ? (up * wu[0] + x * wu[1] + dn * wu[2] + bu) : (up * wg[0] + x * wg[1] + dn * wg[2] + bg);
                    }
                    f32x4 a;
#pragma unroll
                    for (int i = 0; i < 4; ++i) a[i] = cv[0][i] * frcp(1.0f + __expf(-cv[0][i])) * cv[1][i];
                    const u32x2_ pk = {cvt_pk_bf16(a[0], a[1]), cvt_pk_bf16(a[2], a[3])};
                    if (n == 0) keep[ai][m] = pk;
                    else { const u32x4 o = {keep[ai][m].x, keep[ai][m].y, pk.x, pk.y};
                        *(u32x4*)(ACT + (size_t)(u.pm * BM + ai * HALF + wr * 64 + m * 16 + fr) * ff + ch0) = o; }
                } }
#ifndef HOST_EMU
            asm volatile("" ::: "memory");
#endif
        }
    }
};
#ifndef HOST_EMU
template <class Epi, class Sched, bool ALIGN_EPI = false, bool SP2 = false>
__device__ __forceinline__ void gemm_phase(PG8_LAS unsigned char* lds, const Gemm g, const Sched& S, const Epi& E) {
    const int tid = threadIdx.x, wid = __builtin_amdgcn_readfirstlane(tid >> 6), lane = tid & 63, wr = wid >> 2, wc = wid & 3, fr = lane & 15, fq = lane >> 4;
    const int K = g.K, nt = K / BK;
    unsigned voffA[2], voffB[2];
#pragma unroll
    for (int i = 0; i < 2; ++i) { int R, C; stage_rc(tid * 16 + i * 8192, R, C); const int Rb = Epi::PERM ? ((R & ~31) + perm32(R & 31)) : R;
        voffA[i] = (unsigned)(R * K + C) * 2u; voffB[i] = (unsigned)(Rb * K + C) * 2u; }
    const size_t kstep = (size_t)(BK * 2);
    const size_t hstep = (size_t)HALF * K * 2;
    const size_t tstep = 2 * hstep;
    const unsigned ldsw = (unsigned)wid * 1024u;
    const int aoff = lds_byte(wr * 64 + fr, fq * 8), boff = lds_byte(wc * 32 + fr, fq * 8);
#define PG8_SA(b, h) (((b) * 2 + (h)) * HTB)
#define PG8_SB(b, h) ((4 + (b) * 2 + (h)) * HTB)
#define PG8_STAGE(bufoff, gbase, voff) do { _Pragma("unroll") for (int _i = 0; _i < 2; ++_i) \
        __builtin_amdgcn_global_load_lds((const unsigned*)((const char*)(gbase) + (voff)[_i]), (PG8_LAS unsigned*)(lds + (bufoff) + ldsw + _i * 8192), 16, 0, 0); } while (0)
#define PG8_LDA(dst, b, h) do { _Pragma("unroll") for (int m = 0; m < 4; ++m) _Pragma("unroll") for (int k = 0; k < 2; ++k) dst[m][k] = *(const PG8_LAS bf16x8*)(lds + PG8_SA(b, h) + aoff + m * 2048 + k * 1024); } while (0)
#define PG8_LDB(dst, b, h) do { _Pragma("unroll") for (int n = 0; n < 2; ++n) _Pragma("unroll") for (int k = 0; k < 2; ++k) dst[n][k] = *(const PG8_LAS bf16x8*)(lds + PG8_SB(b, h) + boff + n * 2048 + k * 1024); } while (0)
#define PG8_MMA(ai, bj, At, Bt) do { __builtin_amdgcn_s_setprio(1); _Pragma("unroll") for (int m = 0; m < 4; ++m) _Pragma("unroll") for (int n = 0; n < 2; ++n) _Pragma("unroll") for (int k = 0; k < 2; ++k) \
        acc[ai][bj][m][n] = __builtin_amdgcn_mfma_f32_16x16x32_bf16(Bt[n][k], At[m][k], acc[ai][bj][m][n], 0, 0, 0); __builtin_amdgcn_s_setprio(0); } while (0)
#define PG8_WAIT_V(n) asm volatile("s_waitcnt vmcnt(" #n ")" ::: "memory")
#define PG8_WAIT_L(n) asm volatile("s_waitcnt lgkmcnt(" #n ")" ::: "memory")
#define PG8_BAR __builtin_amdgcn_s_barrier()
#define PG8_SCHED __builtin_amdgcn_sched_barrier(0)
    Unit cur, nxt; int ui = 0;
    if (!S.next(0, cur)) return;
    f32x4 acc[2][2][4][2];
#pragma unroll
    for (int a = 0; a < 2; ++a)
#pragma unroll
        for (int b = 0; b < 2; ++b)
#pragma unroll
            for (int m = 0; m < 4; ++m)
#pragma unroll
                for (int n = 0; n < 2; ++n) acc[a][b][m][n] = (f32x4){0.f, 0.f, 0.f, 0.f};
    bf16x8 At[4][2], B0[2][2], B1[2][2];
    const char* cA = (const char*)g.A + (size_t)cur.pm * tstep; const char* cB = (const char*)g.Bt + (size_t)cur.pn * tstep;
    S.a_ready(cur);
    if constexpr (SP2) {
        PG8_STAGE(PG8_SB(0, 0), cB, voffB); PG8_STAGE(PG8_SB(0, 1), cB + hstep, voffB); PG8_STAGE(PG8_SA(0, 0), cA, voffA); PG8_STAGE(PG8_SA(0, 1), cA + hstep, voffA);
        if (wr == 1) PG8_BAR;
        PG8_WAIT_V(2); PG8_BAR;
        PG8_STAGE(PG8_SB(1, 0), cB + kstep, voffB); PG8_STAGE(PG8_SA(1, 0), cA + kstep, voffA); PG8_STAGE(PG8_SB(1, 1), cB + hstep + kstep, voffB);
        PG8_WAIT_V(6); PG8_BAR;
    } else {
        PG8_STAGE(PG8_SB(0, 0), cB, voffB); PG8_STAGE(PG8_SA(0, 0), cA, voffA); PG8_STAGE(PG8_SB(0, 1), cB + hstep, voffB); PG8_STAGE(PG8_SA(0, 1), cA + hstep, voffA);
        if (wr == 1) PG8_BAR;
        PG8_WAIT_V(4); PG8_BAR;
        PG8_STAGE(PG8_SB(1, 0), cB + kstep, voffB); PG8_STAGE(PG8_SA(1, 0), cA + kstep, voffA); PG8_STAGE(PG8_SB(1, 1), cB + hstep + kstep, voffB);
        PG8_WAIT_V(6); PG8_BAR;
    }
    for (;;) {
        const bool has_next = S.next(ui + 1, nxt);
        const char* nA = has_next ? (const char*)g.A + (size_t)nxt.pm * tstep : cA; const char* nB = has_next ? (const char*)g.Bt + (size_t)nxt.pn * tstep : cB;
        for (int t = 0; t < nt; t += 2) {
            const bool last = (t == nt - 2);
            const char* a1 = cA + (size_t)(t + 1) * kstep;
            const char* a2 = last ? nA : cA + (size_t)(t + 2) * kstep; const char* b2 = last ? nB : cB + (size_t)(t + 2) * kstep;
            const char* a3 = a2 + kstep; const char* b3 = b2 + kstep;
            if (last && has_next) S.a_ready(nxt);
            if constexpr (SP2) {
            PG8_LDB(B0, 0, 0); PG8_LDB(B1, 0, 1); PG8_SCHED; PG8_LDA(At, 0, 0); PG8_STAGE(PG8_SA(1, 1), a1 + hstep, voffA);
            PG8_WAIT_V(8); PG8_WAIT_L(0); PG8_BAR; PG8_MMA(0, 0, At, B0); PG8_MMA(0, 1, At, B1); PG8_BAR; PG8_SCHED;
            PG8_LDA(At, 0, 1); PG8_STAGE(PG8_SB(0, 0), b2, voffB); PG8_STAGE(PG8_SB(0, 1), b2 + hstep, voffB); PG8_STAGE(PG8_SA(0, 0), a2, voffA);
            PG8_WAIT_V(8); PG8_WAIT_L(0); PG8_BAR; PG8_MMA(1, 0, At, B0); PG8_MMA(1, 1, At, B1); PG8_BAR; PG8_SCHED;
            PG8_LDB(B0, 1, 0); PG8_LDB(B1, 1, 1); PG8_SCHED; PG8_LDA(At, 1, 0); PG8_STAGE(PG8_SA(0, 1), a2 + hstep, voffA);
            PG8_WAIT_V(8); PG8_WAIT_L(0); PG8_BAR; PG8_MMA(0, 0, At, B0); PG8_MMA(0, 1, At, B1); PG8_BAR; PG8_SCHED;
            PG8_LDA(At, 1, 1); PG8_STAGE(PG8_SB(1, 0), b3, voffB); PG8_STAGE(PG8_SB(1, 1), b3 + hstep, voffB); PG8_STAGE(PG8_SA(1, 0), a3, voffA);
            PG8_WAIT_V(8); PG8_WAIT_L(0); PG8_BAR; PG8_MMA(1, 0, At, B0); PG8_MMA(1, 1, At, B1); PG8_BAR; PG8_SCHED;
            } else {
            PG8_LDB(B0, 0, 0); PG8_SCHED; PG8_LDA(At, 0, 0); PG8_STAGE(PG8_SA(1, 1), a1 + hstep, voffA);
            PG8_WAIT_L(8); PG8_BAR; PG8_WAIT_L(0); PG8_MMA(0, 0, At, B0); PG8_BAR; PG8_SCHED;
            PG8_LDB(B1, 0, 1); PG8_STAGE(PG8_SB(0, 0), b2, voffB);
            PG8_BAR; PG8_WAIT_L(0); PG8_MMA(0, 1, At, B1); PG8_BAR;
            PG8_LDA(At, 0, 1); PG8_STAGE(PG8_SA(0, 0), a2, voffA);
            PG8_BAR; PG8_WAIT_L(0); PG8_MMA(1, 0, At, B0); PG8_BAR; PG8_SCHED;
            PG8_STAGE(PG8_SB(0, 1), b2 + hstep, voffB);
            PG8_WAIT_V(6); PG8_BAR; PG8_MMA(1, 1, At, B1); PG8_BAR;
            PG8_LDB(B0, 1, 0); PG8_SCHED; PG8_LDA(At, 1, 0); PG8_STAGE(PG8_SA(0, 1), a2 + hstep, voffA);
            PG8_WAIT_L(8); PG8_BAR; PG8_WAIT_L(0); PG8_MMA(0, 0, At, B0); PG8_BAR; PG8_SCHED;
            PG8_LDB(B1, 1, 1); PG8_STAGE(PG8_SB(1, 0), b3, voffB);
            PG8_BAR; PG8_WAIT_L(0); PG8_MMA(0, 1, At, B1); PG8_BAR;
            PG8_LDA(At, 1, 1); PG8_STAGE(PG8_SA(1, 0), a3, voffA);
            PG8_BAR; PG8_WAIT_L(0); PG8_MMA(1, 0, At, B0); PG8_BAR; PG8_SCHED;
            PG8_STAGE(PG8_SB(1, 1), b3 + hstep, voffB);
            PG8_WAIT_V(6); PG8_BAR; PG8_MMA(1, 1, At, B1); PG8_BAR;
            }
        }
        if constexpr (ALIGN_EPI) { if (wr == 0) PG8_BAR; }
        if constexpr (!Epi::AFTER_DRAIN) { E(acc, cur, wr, wc, fr, fq); S.done(cur); }
        if (!has_next) break;
#pragma unroll
        for (int a = 0; a < 2; ++a)
#pragma unroll
            for (int b = 0; b < 2; ++b)
#pragma unroll
                for (int m = 0; m < 4; ++m)
#pragma unroll
                    for (int n = 0; n < 2; ++n) acc[a][b][m][n] = (f32x4){0.f, 0.f, 0.f, 0.f};
        cur = nxt; cA = nA; cB = nB; ++ui;
        if constexpr (ALIGN_EPI) { if (wr == 1) PG8_BAR; }
    }
    PG8_WAIT_V(0);
    if constexpr (!ALIGN_EPI) { if (wr == 0) PG8_BAR; }
    PG8_BAR;
    if constexpr (Epi::AFTER_DRAIN) { E.fused(acc, cur, wr, wc, fr, fq, lds, wid, lane); S.done(cur); }
#undef PG8_SA
#undef PG8_SB
#undef PG8_STAGE
#undef PG8_LDA
#undef PG8_LDB
#undef PG8_MMA
#undef PG8_WAIT_V
#undef PG8_WAIT_L
#undef PG8_BAR
#undef PG8_SCHED
}
}
#endif

#ifdef HOST_EMU
template <class Epi, class Sched, bool A_ = false, bool B_ = false>
void gemm_phase(unsigned char*, const Gemm g, const Sched& S, const Epi& E) {
    const int tid = threadIdx.x, wid = tid >> 6, lane = tid & 63, wr = wid >> 2, wc = wid & 3, fr = lane & 15, fq = lane >> 4;
    const int nN = g.N / 256, nU = (g.M / 256) * nN;
    for (int u = S.c; u < nU; u += S.G) { Unit un{u / nN, u % nN}; f32x4 acc[2][2][4][2];
        for (int ai = 0; ai < 2; ++ai) for (int bj = 0; bj < 2; ++bj) for (int m = 0; m < 4; ++m) for (int n = 0; n < 2; ++n) for (int i = 0; i < 4; ++i) {
            const int row = un.pm * 256 + 128 * ai + 64 * wr + 16 * m + fr, col = un.pn * 256 + 128 * bj + 32 * wc + (Epi::PERM ? 8 * fq + 4 * n + i : 16 * n + 4 * fq + i);
            float s = 0.f; for (int k = 0; k < g.K; ++k) s += bf2f(g.A[(size_t)row * g.K + k]) * bf2f(g.Bt[(size_t)col * g.K + k]);
            acc[ai][bj][m][n][i] = s; }
        E(acc, un, wr, wc, fr, fq); }
}
}
#endif
#ifndef PG8_SP2
#define PG8_SP2 true
#endif
#ifndef PG8_ALIGN
#define PG8_ALIGN true
#endif

constexpr int NWAVES = 8, NTHR = NWAVES * 64;
enum Phase { PH_PRO = 0, PH_EIN, PH_EMA, PH_EMB, PH_EMC, PH_EOUT, PH_LN1A, PH_UP0, PH_CG0, PH_DN0, PH_LN2A,
             PH_OIN, PH_OMA, PH_OMB, PH_OMC, PH_OMD, PH_OOUT, PH_LN1B, PH_UP1, PH_CG1, PH_DN1, PH_LN2B, NPH };
#ifndef MK_ONE_LAUNCH
#define MK_ONE_LAUNCH 1
#endif

constexpr size_t alup(size_t x) { return (x + 4095) & ~(size_t)4095; }
constexpr size_t WS_CTL = 0, CTL_ZERO_BYTES = 1u << 20;
constexpr size_t WS_WEIN = CTL_ZERO_BYTES,                 SZ_WEIN = alup((size_t)EIN_P * DM * 2);
constexpr size_t WS_WEOUT = WS_WEIN + SZ_WEIN,             SZ_WEOUT = alup((size_t)DM * EMIX * 2);
constexpr size_t WS_WOIN = WS_WEOUT + SZ_WEOUT,            SZ_WOIN = alup((size_t)OIN_P * DM * 2);
constexpr size_t WS_WOOUT = WS_WOIN + SZ_WOIN,             SZ_WOOUT = alup((size_t)DM * OMIX * 2);
constexpr size_t WS_WUP = WS_WOOUT + SZ_WOOUT,             SZ_WUP1 = alup((size_t)FF2 * DM * 2);
constexpr size_t WS_WDN = WS_WUP + NLAYER * SZ_WUP1,       SZ_WDN1 = alup((size_t)DM * FF * 2);
constexpr size_t WS_XB = WS_WDN + NLAYER * SZ_WDN1,        SZ_XB = alup((size_t)T * DM * 2);
constexpr size_t WS_WLT = WS_XB + SZ_XB,                 SZ_WLT = alup((size_t)2 * LNB * 2 * 128 * 128 * 2);
constexpr size_t WS_STATS = WS_WLT + SZ_WLT,             SZ_STATS = alup((size_t)T * 2 * 4);
constexpr size_t WS_OVL = WS_STATS + SZ_STATS;
constexpr size_t WS_H = WS_OVL,                            SZ_H = alup((size_t)(T / 256) * 4 * FF2 * 4);
constexpr size_t WS_ACT = WS_H + SZ_H,                     SZ_ACT = alup((size_t)T * FF * 2);
constexpr int PROJ_LD = EIN_P > OIN_P ? EIN_P : OIN_P, MIX_LD = EMIX > OMIX ? EMIX : OMIX;
constexpr size_t WS_PROJ = WS_OVL,                         SZ_PROJ = alup((size_t)T * PROJ_LD * 2);
constexpr size_t WS_MIX = WS_PROJ + SZ_PROJ,               SZ_MIX = alup((size_t)T * MIX_LD * 2);
constexpr size_t WS_SCR = WS_MIX + SZ_MIX;
constexpr size_t WS_END_FFN = WS_ACT + SZ_ACT;
constexpr int CW_TMO = 0, CW_BAR = 4096;

constexpr int RING_OFF = 0, RING_BYTES = 131072;
constexpr int LDSCTL_OFF = RING_BYTES, MISC_OFF = LDSCTL_OFF + 320, EDGE_OFF = LDSCTL_OFF + 1024;
constexpr int LDS_BYTES = 147456;

typedef GAS unsigned gu32;
#define RLX_AGENT __ATOMIC_RELAXED, __HIP_MEMORY_SCOPE_AGENT

#ifndef HOST_EMU
#define XB_TMO      128
#define XB_XCNT(j)  (256  + 64 * (j))
#define XB_XSUB(j)  (1280 + 64 * (j))
#define XB_XGEN(j)  (2304 + 64 * (j))
#define XB_TOP      3328
#define XB_TOPGEN   3392
#define XCD_BAR_WORDS 3456
#define XB_SPIN_CAP (1u << 18)

__device__ __forceinline__ unsigned xb_ld(unsigned* p)              { return __hip_atomic_load(p, __ATOMIC_RELAXED, __HIP_MEMORY_SCOPE_AGENT); }
__device__ __forceinline__ unsigned xb_add(unsigned* p, unsigned v) { return __hip_atomic_fetch_add(p, v, __ATOMIC_RELAXED, __HIP_MEMORY_SCOPE_AGENT); }
__device__ __forceinline__ unsigned xb_xcc_id() { return (unsigned)__builtin_amdgcn_s_getreg((3 << 11) | 20) & 0xFu; }
#define XB_SPIN(cond, bar) do { unsigned _sp = 0; while (cond) { __builtin_amdgcn_s_sleep(1); \
    if ((++_sp & 255u) == 0u) { if (xb_ld(&(bar)[XB_TMO])) break; if (_sp > XB_SPIN_CAP) { atomicAdd(&(bar)[XB_TMO], 1u); break; } } } } while (0)

struct XcdBarrier {
    unsigned* bar; unsigned x;
    volatile LAS unsigned* st;
};

__device__ __forceinline__ XcdBarrier xcd_barrier_post(unsigned* bar, volatile LAS unsigned* st) {
    XcdBarrier b; b.bar = bar; b.x = xb_xcc_id(); b.st = st;
    if (threadIdx.x == 0) (void)xb_add(&bar[XB_XCNT(b.x)], 1u);
    return b;
}
__device__ __forceinline__ void xcd_barrier_complete(unsigned* bar, unsigned x, unsigned& nloc, unsigned& nx) {
    const unsigned G = gridDim.x * gridDim.y * gridDim.z;
    unsigned sum, cnt, mine, sp = 0u;
    for (;;) {
        sum = 0u; cnt = 0u; mine = 0u;
#pragma unroll
        for (unsigned j = 0; j < 16; ++j) { const unsigned c = xb_ld(&bar[XB_XCNT(j)]); sum += c; cnt += (c > 0u) ? 1u : 0u; mine = (j == x) ? c : mine; }
        if (sum == G) break;
        __builtin_amdgcn_s_sleep(1);
        if ((++sp & 255u) == 0u) { if (xb_ld(&bar[XB_TMO])) break; if (sp > XB_SPIN_CAP) { atomicAdd(&bar[XB_TMO], 1u); break; } }
    }
    nloc = mine > 0u ? mine : 1u; nx = cnt > 0u ? cnt : 1u;
}

__device__ __forceinline__ void xcd_barrier(const XcdBarrier& b) {
    asm volatile("s_waitcnt vmcnt(0)" ::: "memory");
    __syncthreads();
    if (threadIdx.x == 0) {
        unsigned* bar = b.bar;
        __builtin_amdgcn_s_waitcnt(0);
        unsigned nloc = b.st[0], nx = b.st[1];
        if (nloc == 0u) { xcd_barrier_complete(bar, b.x, nloc, nx); b.st[0] = nloc; b.st[1] = nx; }
        const unsigned old = xb_add(&bar[XB_XSUB(b.x)], 1u);
        const unsigned gen = old / nloc;
        if (old + 1u == (gen + 1u) * nloc) {
            __builtin_amdgcn_fence(__ATOMIC_RELEASE, "agent");
            asm volatile("s_waitcnt vmcnt(0)" ::: "memory");
            const unsigned og = xb_add(&bar[XB_TOP], 1u);
            const unsigned tg = og / nx;
            if (og + 1u == (tg + 1u) * nx) xb_add(&bar[XB_TOPGEN], 1u);
            else XB_SPIN(xb_ld(&bar[XB_TOPGEN]) == tg, bar);
            __builtin_amdgcn_fence(__ATOMIC_ACQUIRE, "agent");
            xb_add(&bar[XB_XGEN(b.x)], 1u);
            asm volatile("s_waitcnt vmcnt(0)" ::: "memory");
        } else {
            XB_SPIN(xb_ld(&bar[XB_XGEN(b.x)]) == gen, bar);
            __builtin_amdgcn_fence(__ATOMIC_ACQUIRE, "agent");
            asm volatile("s_waitcnt vmcnt(0)" ::: "memory");
        }
    }
    __syncthreads();
}

#endif

struct Frame {
    LAS unsigned char* lds;
    volatile LAS unsigned* MISC;
    gu32* ctl;
    int tid, lane, wave;
    int vcu, G;
    float* out; unsigned char* ws;
};
DI float wave_sum(float v) {
#pragma unroll
    for (int o = 1; o < 64; o <<= 1) v += __shfl_xor(v, o);
    return v;
}

DI void p0_transpose_item(const float* W, int K, int N, bf16* WT, LAS float* scr, int item, int lane, int gate_ff = 0) {
    const int nblk = N / 32, kb = item / nblk, nb = item % nblk, k0 = 64 * kb, n0 = 32 * nb;
    const int r0 = gate_ff ? (n0 < gate_ff ? (n0 / 128) * 256 + n0 % 128 : ((n0 - gate_ff) / 128) * 256 + 128 + (n0 - gate_ff) % 128) : n0;
#pragma unroll 8
    for (int i = 0; i < 32; ++i) { const int kk = 2 * i + (lane >> 5); scr[kk * 33 + (lane & 31)] = W[(size_t)(k0 + kk) * N + n0 + (lane & 31)]; }
    WAVE_SYNC();
    const int c = lane & 7;
#pragma unroll
    for (int j = 0; j < 4; ++j) { const int n = (lane >> 3) + 8 * j; const LAS float* s = scr + (8 * c) * 33 + n;
        v4u o; o.x = pk2(s[0 * 33], s[1 * 33]); o.y = pk2(s[2 * 33], s[3 * 33]); o.z = pk2(s[4 * 33], s[5 * 33]); o.w = pk2(s[6 * 33], s[7 * 33]);
        *(v4u*)(WT + (size_t)(r0 + n) * K + k0 + 8 * c) = o; }
    WAVE_SYNC();
}
DI void zero_fill16(Frame& F, void* p, size_t bytes) {
    v4u* q = (v4u*)p; const size_t n = bytes / 16; const v4u z = {0u, 0u, 0u, 0u};
    for (size_t i = (size_t)F.vcu * NTHR + F.tid; i < n; i += (size_t)F.G * NTHR) q[i] = z;
}
struct WSrc { const float *w_ein, *w_eout, *w_oin, *w_oout, *w_up, *w_dn; };
constexpr int I_EIN = (DM / 64) * (EIN / 32), I_EOUT = (EMIX / 64) * (DM / 32), I_OIN = (DM / 64) * (OIN / 32), I_OOUT = (OMIX / 64) * (DM / 32);
constexpr int I_UP = (DM / 64) * (FF2 / 32), I_DN = (FF / 64) * (DM / 32);
constexpr int N_EARLY = I_EIN + I_EOUT + I_UP + I_DN, N_LATE = I_OIN + I_OOUT + I_UP + I_DN;
constexpr int LATE_A = N_LATE * 28 / 100, LATE_B = N_LATE * 36 / 100;
DI void conv_early_item(Frame& F, const WSrc& S, int r, LAS float* scr) {
    if (r < I_EIN) { p0_transpose_item(S.w_ein, DM, EIN, (bf16*)(F.ws + WS_WEIN), scr, r, F.lane); return; } r -= I_EIN;
    if (r < I_EOUT) { p0_transpose_item(S.w_eout, EMIX, DM, (bf16*)(F.ws + WS_WEOUT), scr, r, F.lane); return; } r -= I_EOUT;
    if (r < I_UP) { p0_transpose_item(S.w_up, DM, FF2, (bf16*)(F.ws + WS_WUP), scr, r, F.lane, FF); return; } r -= I_UP;
    p0_transpose_item(S.w_dn, FF, DM, (bf16*)(F.ws + WS_WDN), scr, r, F.lane);
}
DI void conv_late_item(Frame& F, const WSrc& S, int r, LAS float* scr) {
    if (r < I_OIN) { p0_transpose_item(S.w_oin, DM, OIN, (bf16*)(F.ws + WS_WOIN), scr, r, F.lane); return; } r -= I_OIN;
    if (r < I_OOUT) { p0_transpose_item(S.w_oout, OMIX, DM, (bf16*)(F.ws + WS_WOOUT), scr, r, F.lane); return; } r -= I_OOUT;
    if (r < I_UP) { p0_transpose_item(S.w_up + (size_t)DM * FF2, DM, FF2, (bf16*)(F.ws + WS_WUP + SZ_WUP1), scr, r, F.lane, FF); return; } r -= I_UP;
    p0_transpose_item(S.w_dn + (size_t)FF * DM, FF, DM, (bf16*)(F.ws + WS_WDN + SZ_WDN1), scr, r, F.lane);
}
DI void conv_late_tail(Frame& F, const WSrc& S, int nwg, int c, int lo, int hi) {
    const int rem = nwg % F.G;
    if (c < rem) return;
    LAS float* scr = (LAS float*)(F.lds + RING_OFF + F.wave * 16384);
    const int nl = (F.G - rem) * NWAVES;
    for (int it = lo + (c - rem) * NWAVES + F.wave; it < hi; it += nl) conv_late_item(F, S, it, scr);
}
DI void p0_prologue(Frame& F, const float* x_p, const float* x_s, const WSrc& S) {
    LAS float* scr = (LAS float*)(F.lds + RING_OFF + F.wave * 16384);
    const int gw = F.vcu * NWAVES + F.wave, NGW = F.G * NWAVES;
    for (int it = gw; it < N_EARLY; it += NGW) conv_early_item(F, S, it, scr);
    for (int it = LATE_A + LATE_B + gw; it < N_LATE; it += NGW) conv_late_item(F, S, it, scr);
    if (EIN_P > EIN) zero_fill16(F, (bf16*)(F.ws + WS_WEIN) + (size_t)EIN * DM, (size_t)(EIN_P - EIN) * DM * 2);
    if (OIN_P > OIN) zero_fill16(F, (bf16*)(F.ws + WS_WOIN) + (size_t)OIN * DM, (size_t)(OIN_P - OIN) * DM * 2);
    bf16* XB = (bf16*)(F.ws + WS_XB);
    const size_t nq = (size_t)T * DM / 4, npq = (size_t)NSEQ_P * SEQ * DM / 4;
    for (size_t i = (size_t)F.vcu * NTHR + F.tid; i < nq; i += (size_t)F.G * NTHR) {
        const v4f v = (i < npq) ? ((const v4f*)x_p)[i] : ((const v4f*)x_s)[i - npq];
        v2u o; o.x = pk2(v.x, v.y); o.y = pk2(v.z, v.w); ((v2u*)XB)[i] = o;
    }
}

template <bool FINAL> DI void ln_phase(Frame& F, const bf16* Y, float* Xout, bf16* XBo, float* stats, const float* g, const float* b) {
    constexpr int NV = DM / 256;
    static_assert(T % 2 == 0 && DM * 8 <= RING_BYTES, "ln_phase: row pairs, affine vectors in LDS");
    LAS v4f* gl = (LAS v4f*)(F.lds + RING_OFF); LAS v4f* bl = gl + DM / 4;
    __syncthreads();
    for (int i = F.tid; i < DM / 4; i += NTHR) { gl[i] = ((const v4f*)g)[i]; bl[i] = ((const v4f*)b)[i]; }
    __syncthreads();
    const int gw = F.vcu * NWAVES + F.wave, NGW = F.G * NWAVES;
#pragma unroll 1
    for (int m = 2 * gw; m < T; m += 2 * NGW) {
        const v2u* ya_ = (const v2u*)(Y + (size_t)m * DM) + F.lane; const v2u* yb_ = ya_ + DM / 4;
        v4f va[NV], vb[NV]; float sa = 0.f, sb = 0.f;
        { v2u ra_[NV], rb_[NV];
#pragma unroll
          for (int j = 0; j < NV; ++j) { ra_[j] = ya_[64 * j]; rb_[j] = yb_[64 * j]; }
#pragma unroll
          for (int j = 0; j < NV; ++j) { va[j] = (v4f){bflo(ra_[j].x), bfhi(ra_[j].x), bflo(ra_[j].y), bfhi(ra_[j].y)}; vb[j] = (v4f){bflo(rb_[j].x), bfhi(rb_[j].x), bflo(rb_[j].y), bfhi(rb_[j].y)}; } }
#pragma unroll
        for (int j = 0; j < NV; ++j) { sa += (va[j].x + va[j].y) + (va[j].z + va[j].w); sb += (vb[j].x + vb[j].y) + (vb[j].z + vb[j].w); }
#pragma unroll
        for (int o = 1; o < 64; o <<= 1) { const float ta = __shfl_xor(sa, o), tb = __shfl_xor(sb, o); sa += ta; sb += tb; }
        const float ma = sa * (1.f / DM), mb = sb * (1.f / DM); float qa = 0.f, qb = 0.f;
#pragma unroll
        for (int j = 0; j < NV; ++j) { va[j] = va[j] - ma; vb[j] = vb[j] - mb;
            qa += (va[j].x * va[j].x + va[j].y * va[j].y) + (va[j].z * va[j].z + va[j].w * va[j].w); qb += (vb[j].x * vb[j].x + vb[j].y * vb[j].y) + (vb[j].z * vb[j].z + vb[j].w * vb[j].w); }
#pragma unroll
        for (int o = 1; o < 64; o <<= 1) { const float ta = __shfl_xor(qa, o), tb = __shfl_xor(qb, o); qa += ta; qb += tb; }
        const float ra = frsq(qa * (1.f / DM) + LN_EPS), rb = frsq(qb * (1.f / DM) + LN_EPS);
        if (!FINAL && F.lane == 0) { *(v4f*)(stats + 2 * m) = (v4f){ma, ra, mb, rb}; }
        v2u* oa = (v2u*)(XBo + (size_t)m * DM) + F.lane; v2u* ob = oa + DM / 4;
#pragma unroll
        for (int j = 0; j < NV; ++j) { if ((j & 3) == 0) CFENCE();
            const v4f gg = gl[F.lane + 64 * j], bb = bl[F.lane + 64 * j];
            const v4f ya = va[j] * ra * gg + bb, yb = vb[j] * rb * gg + bb;
            if (FINAL) { v4f* xa = (v4f*)(Xout + (size_t)m * DM) + F.lane; xa[64 * j] = ya; xa[DM / 4 + 64 * j] = yb; }
            else { v2u o; o.x = pk2(ya.x, ya.y); o.y = pk2(ya.z, ya.w); oa[64 * j] = o; o.x = pk2(yb.x, yb.y); o.y = pk2(yb.z, yb.w); ob[64 * j] = o; } }
    }
}

static_assert(FF % 128 == 0 && SEQ % 256 == 0, "fused conv+gate tiling");
DI void convgate_fix_phase(Frame& F, const float* EDGEG, bf16* ACT, const float* cw, const float* cb) {
    constexpr int NT = T / 256, NQ = FF / 4;
    const size_t total = (size_t)NT * 2 * NQ;
    for (size_t idx = (size_t)F.vcu * NTHR + F.tid; idx < total; idx += (size_t)F.G * NTHR) {
        const int q = (int)(idx % NQ), which = (int)((idx / NQ) & 1), pm = (int)(idx / (2 * NQ));
        const int c = 4 * q, pn = c / 128, lcol = c % 128, gi = pn * 256 + lcol, ui = gi + 128;
        const int row = pm * 256 + (which ? 255 : 0);
        const float* e = EDGEG + (size_t)pm * 4 * FF2;
        const v4f z = {0.f, 0.f, 0.f, 0.f};
        v4f gp, gc, gn, up, uc, un;
        if (!which) { const bool first = (row % SEQ) == 0;
            gp = first ? z : *(const v4f*)(e - (size_t)FF2 + gi); up = first ? z : *(const v4f*)(e - (size_t)FF2 + ui);
            gc = *(const v4f*)(e + gi); uc = *(const v4f*)(e + ui); gn = *(const v4f*)(e + FF2 + gi); un = *(const v4f*)(e + FF2 + ui);
        } else { const bool last = ((row + 1) % SEQ) == 0;
            gp = *(const v4f*)(e + 2 * (size_t)FF2 + gi); up = *(const v4f*)(e + 2 * (size_t)FF2 + ui); gc = *(const v4f*)(e + 3 * (size_t)FF2 + gi); uc = *(const v4f*)(e + 3 * (size_t)FF2 + ui);
            gn = last ? z : *(const v4f*)(e + 4 * (size_t)FF2 + gi); un = last ? z : *(const v4f*)(e + 4 * (size_t)FF2 + ui); }
        const v4f g = gp * *(const v4f*)(cw + c) + gc * *(const v4f*)(cw + FF2 + c) + gn * *(const v4f*)(cw + 2 * (size_t)FF2 + c) + *(const v4f*)(cb + c);
        const v4f u = up * *(const v4f*)(cw + FF + c) + uc * *(const v4f*)(cw + FF2 + FF + c) + un * *(const v4f*)(cw + 2 * (size_t)FF2 + FF + c) + *(const v4f*)(cb + FF + c);
        v2u o; o.x = pk2(siluf_(g.x) * u.x, siluf_(g.y) * u.y); o.y = pk2(siluf_(g.z) * u.z, siluf_(g.w) * u.w);
        *(v2u*)(ACT + (size_t)row * FF + c) = o;
    }
}

constexpr int NCH = SEQ / GCH;
constexpr int FN = 2 * SEQ, FNH = SEQ;
constexpr int NPAIR = NSEQ / 2;
static_assert(NSEQ % 2 == 0 && (FN & (FN - 1)) == 0, "hyena FFT geometry");
constexpr size_t WS_QD = WS_SCR,                 SZ_QD = alup((size_t)2 * T * GQK * 2);
constexpr size_t WS_KIT = WS_QD + SZ_QD,         SZ_KIT = SZ_QD;
constexpr size_t WS_SC = WS_KIT + SZ_KIT,        SZ_SC = alup((size_t)2 * NSEQ * NCH * GH * 64 * 64 * 2);
constexpr size_t WS_DEC = WS_SC + SZ_SC,         SZ_DEC = alup((size_t)2 * NSEQ * NCH * GH * 256 * 4);
constexpr size_t WS_OF = WS_DEC + SZ_DEC,        SZ_OF = alup((size_t)2 * T * GV * 4);
constexpr size_t WS_TW = WS_OF + SZ_OF,          SZ_TW = alup((size_t)FNH * 8);
constexpr size_t WS_H2 = WS_TW + SZ_TW,          SZ_H2 = alup((size_t)SEQ * HFH * 4);
constexpr size_t WS_KF = WS_H2 + SZ_H2,          SZ_KF = alup((size_t)HW * FN * 8);
constexpr size_t WS_UT = WS_KF + SZ_KF,          SZ_UT = alup((size_t)NSEQ * HW * SEQ * 4);
constexpr size_t WS_END_EVEN = WS_UT + SZ_UT;
static_assert((size_t)NSEQ * HW * SEQ * 4 <= SZ_XB, "YT fits in XB");

DI v4f mma16(v8s a, v8s b, v4f c) { return __builtin_amdgcn_mfma_f32_16x16x32_bf16(a, b, c, 0, 0, 0); }
DI v8s ldfrag(const LAS bf16* base, int row, int ld, int k0) { return *(const LAS v8s*)(base + row * ld + k0); }

DI void hyena_pro(Frame& F, const float* w1, const float* b1, const float* w2, const float* b2) {
    float* H2 = (float*)(F.ws + WS_H2); v2f* TW = (v2f*)(F.ws + WS_TW);
    const int gt = F.vcu * NTHR + F.tid, NT = F.G * NTHR;
    for (int k = gt; k < FNH; k += NT) { float s, c; sincospif((float)k * (2.0f / (float)FN), &s, &c); TW[k] = (v2f){c, -s}; }
    LAS float* h1 = (LAS float*)(F.lds + RING_OFF);
    __syncthreads();
    const int j = F.tid & 63, rr = F.tid >> 6;
#pragma unroll 1
    for (int t0 = F.vcu * 8; t0 < SEQ; t0 += F.G * 8) {
        const int t = t0 + rr;
        float acc = b1[j];
        {   const float tl = (float)t / (float)(SEQ - 1);
            acc += tl * w1[j];
            const float w = 6.283185307179586f * (float)t / (float)SEQ;
#pragma unroll 4
            for (int b = 0; b < HBANDS; ++b) { const float band = 1e-4f + (float)b * ((float)(HBANDS - 1) - 1e-4f) / (float)(HBANDS - 1);
                const float ang = band * w; acc += cosf(ang) * w1[(1 + b) * HFH + j] - sinf(ang) * w1[(1 + HBANDS + b) * HFH + j]; }
        }
        h1[rr * 64 + j] = sinf(acc);
        __syncthreads();
        float a2 = b2[j];
#pragma unroll 8
        for (int i = 0; i < HFH; ++i) a2 += h1[rr * 64 + i] * w2[i * HFH + j];
        H2[(size_t)t * HFH + j] = sinf(a2);
        __syncthreads();
    }
}

constexpr int ilog2c(int n) { return n <= 1 ? 0 : 1 + ilog2c(n >> 1); }
constexpr int LOGFN = ilog2c(FN), NP16 = LOGFN / 4;
static_assert(LOGFN % 4 == 1, "FFT: radix-16 passes plus exactly one radix-2 stage");
#define PH(i) ((i) + ((i) >> 5))
DI v2f cmul(v2f a, v2f b) { return (v2f){a.x * b.x - a.y * b.y, a.x * b.y + a.y * b.x}; }
DI v2f cmulc(v2f a, v2f b) { return (v2f){a.x * b.x + a.y * b.y, a.y * b.x - a.x * b.y}; }
#define R16C(k) ((k) == 0 ? 1.0f : (k) == 1 ? 0.9238795325112867f : (k) == 2 ? 0.7071067811865476f : (k) == 3 ? 0.3826834323650898f : (k) == 4 ? 0.0f : (k) == 5 ? -0.3826834323650898f : (k) == 6 ? -0.7071067811865476f : -0.9238795325112867f)
#define R16S(k) ((k) == 0 ? 0.0f : (k) == 1 ? -0.3826834323650898f : (k) == 2 ? -0.7071067811865476f : (k) == 3 ? -0.9238795325112867f : (k) == 4 ? -1.0f : (k) == 5 ? -0.9238795325112867f : (k) == 6 ? -0.7071067811865476f : -0.3826834323650898f)
constexpr int fft_twoff(int p) { return p == 0 ? 0 : fft_twoff(p - 1) + (FN >> (4 * p)); }
constexpr int FFT_NTW = fft_twoff(NP16);
template <int P, bool INV> DI void fft_pass16(LAS v2f* d, const LAS v2f* tw, int tid) {
    constexpr int Q = FN >> (4 * (P + 1));
    for (int g = tid; g < FN / 16; g += NTHR) {
        const int q = g % Q, base = (g / Q) * (16 * Q) + q;
        v2f x[16];
#pragma unroll
        for (int m = 0; m < 16; ++m) x[m] = d[PH(base + Q * m)];
        v2f bs[4]; bs[0] = tw[fft_twoff(P) + q]; bs[1] = cmul(bs[0], bs[0]); bs[2] = cmul(bs[1], bs[1]); bs[3] = cmul(bs[2], bs[2]);
#pragma unroll
        for (int s0 = 0; s0 < 4; ++s0) { const int s = INV ? 3 - s0 : s0, dist = 8 >> s;
#pragma unroll
            for (int m = 0; m < 16; ++m) if ((m & dist) == 0) { const int r = m & (dist - 1), kk = r * (8 / dist);
                const v2f w = cmul(bs[s], (v2f){R16C(kk), R16S(kk)});
                if (!INV) { const v2f a = x[m], b = x[m + dist]; x[m] = a + b; x[m + dist] = cmul(a - b, w); }
                else { const v2f a = x[m], b = cmulc(x[m + dist], w); x[m] = a + b; x[m + dist] = a - b; } } }
#pragma unroll
        for (int m = 0; m < 16; ++m) d[PH(base + Q * m)] = x[m];
    }
    __syncthreads();
}
DI void fft_last2(LAS v2f* d, int tid) {
    for (int g = tid; g < FN / 2; g += NTHR) { const int i = PH(2 * g); const v2f a = d[i], b = d[i + 1]; d[i] = a + b; d[i + 1] = a - b; }
    __syncthreads();
}
template <int P> DI void fft_dif_from(LAS v2f* d, const LAS v2f* tw, int tid) { if constexpr (P < NP16) { fft_pass16<P, false>(d, tw, tid); fft_dif_from<P + 1>(d, tw, tid); } }
template <int P> DI void fft_idit_from(LAS v2f* d, const LAS v2f* tw, int tid) { if constexpr (P >= 0) { fft_pass16<P, true>(d, tw, tid); fft_idit_from<P - 1>(d, tw, tid); } }
DI void fft_dif(LAS v2f* d, const LAS v2f* tw, int tid) { fft_dif_from<0>(d, tw, tid); fft_last2(d, tid); }
constexpr int NMID = FN / 2 / NTHR > 0 ? FN / 2 / NTHR : 1;
DI void fft_mid_conv(LAS v2f* d, const v4f (&kf)[NMID], int tid) {
#pragma unroll
    for (int k = 0; k < NMID; ++k) { const int g = tid + NTHR * k; if (g < FN / 2) { const int i = PH(2 * g); const v2f a = d[i], b = d[i + 1];
        const v2f p = cmul(a + b, (v2f){kf[k].x, kf[k].y}), q = cmul(a - b, (v2f){kf[k].z, kf[k].w}); d[i] = p + q; d[i + 1] = p - q; } }
    __syncthreads();
}
DI void fft_idit(LAS v2f* d, const LAS v2f* tw, int tid) { fft_last2(d, tid); fft_idit_from<NP16 - 1>(d, tw, tid); }
constexpr int FFT_D_OFF = 0, FFT_TW_OFF = (FN + FN / 32) * 8, FFT_AUX_OFF = FFT_TW_OFF + ((FFT_NTW * 8 + 255) & ~255);
static_assert(FFT_AUX_OFF + 1024 <= RING_BYTES, "fft lds");
DI void fft_load_tw(Frame& F) {
    const v2f* TW = (const v2f*)(F.ws + WS_TW); LAS v2f* tw = (LAS v2f*)(F.lds + FFT_TW_OFF);
    for (int k = F.tid; k < FFT_NTW; k += NTHR) { int p = 0; while (p + 1 < NP16 && k >= fft_twoff(p + 1)) ++p; tw[k] = TW[(k - fft_twoff(p)) << (4 * p)]; }
}
DI void hyena_filter_unit(Frame& F, int c, const float* w3) {
    LAS v2f* d = (LAS v2f*)(F.lds + FFT_D_OFF); const LAS v2f* tw = (const LAS v2f*)(F.lds + FFT_TW_OFF); LAS float* wc = (LAS float*)(F.lds + FFT_AUX_OFF);
    const float* H2 = (const float*)(F.ws + WS_H2);
    __syncthreads();
    if (F.tid < 128) wc[F.tid] = w3[(size_t)(F.tid & 63) * (2 * HW) + (F.tid >> 6) * HW + c];
    fft_load_tw(F);
    __syncthreads();
    const float min_decay = -3.0701134573253945f, max_decay = -15.350567286626972f;
    const float delta = min_decay + (max_decay - min_decay) * (float)c / (float)(HW - 1);
#pragma unroll 1
    for (int t = F.tid; t < SEQ; t += NTHR) {
        const v4f* hr = (const v4f*)(H2 + (size_t)t * HFH); float sf = 0.f, sb = 0.f;
#pragma unroll
        for (int q = 0; q < HFH / 4; ++q) { const v4f h = hr[q];
            sf += h.x * wc[4 * q] + h.y * wc[4 * q + 1] + h.z * wc[4 * q + 2] + h.w * wc[4 * q + 3];
            sb += h.x * wc[64 + 4 * q] + h.y * wc[64 + 4 * q + 1] + h.z * wc[64 + 4 * q + 2] + h.w * wc[64 + 4 * q + 3]; }
        const float win = __expf(-((float)t / (float)(SEQ - 1)) * fabsf(delta));
        d[PH(t)] = (v2f){sf * win, 0.f};
        if (t == 0) d[PH(SEQ)] = (v2f){0.f, 0.f}; else d[PH(FN - t)] = (v2f){sb * win, 0.f};
    }
    __syncthreads();
    fft_dif(d, tw, F.tid);
    v2f* KF = (v2f*)(F.ws + WS_KF) + (size_t)c * FN;
    for (int i = F.tid; i < FN; i += NTHR) KF[i] = d[PH(i)];
}
constexpr int HT = 128;
static_assert(SEQ % HT == 0 && NTHR % HT == 0 && HT % 8 == 0, "hyena tile");
DI void hyena_prep_unit(Frame& F, int unit, const float* cw, const float* cb) {
    constexpr int CT = HW / 64, TT = SEQ / HT, TPT = HT / 8, CG = NTHR / HT, CPT = 64 / CG;
    const int ct = unit % CT, tt = (unit / CT) % TT, seq = unit / (CT * TT);
    const bf16* PROJ = (const bf16*)(F.ws + WS_PROJ); bf16* UT = (bf16*)(F.ws + WS_UT);
    LAS float* tile = (LAS float*)(F.lds + RING_OFF);
    LAS bf16* raw = (LAS bf16*)(F.lds + RING_OFF + 64 * (HT + 1) * 4);
    const bf16* base = PROJ + (size_t)(seq * SEQ) * EIN_P + E_HY + ct * 64;
    __syncthreads();
    for (int q = F.tid; q < 2 * (HT + 2) * 8; q += NTHR) { const int ten = q / ((HT + 2) * 8), rem = q - ten * (HT + 2) * 8, row = rem >> 3, c8 = rem & 7, s = tt * HT - 1 + row;
        v4u v = {0u, 0u, 0u, 0u};
        if (s >= 0 && s < SEQ) v = *(const v4u*)(base + (size_t)s * EIN_P + (1 + ten) * HW + c8 * 8);
        *(LAS v4u*)(raw + (ten * (HT + 2) + row) * 64 + c8 * 8) = v; }
    const int cl = F.tid & 63, tq = F.tid >> 6, c = ct * 64 + cl;
    const int j1 = HW + c, jv = 2 * HW + c;
    const float w1a = cw[j1], w1b = cw[3 * HW + j1], w1c = cw[6 * HW + j1], b1 = cb[j1];
    const float wva = cw[jv], wvb = cw[3 * HW + jv], wvc = cw[6 * HW + jv], bv = cb[jv];
    __syncthreads();
#pragma unroll
    for (int i = 0; i < TPT; ++i) { const int r = tq * TPT + i + 1;
        const float x1 = bf2f(raw[(r - 1) * 64 + cl]) * w1a + bf2f(raw[r * 64 + cl]) * w1b + bf2f(raw[(r + 1) * 64 + cl]) * w1c + b1;
        const float v = bf2f(raw[(HT + 2 + r - 1) * 64 + cl]) * wva + bf2f(raw[(HT + 2 + r) * 64 + cl]) * wvb + bf2f(raw[(HT + 2 + r + 1) * 64 + cl]) * wvc + bv;
        tile[cl * (HT + 1) + tq * TPT + i] = v * x1; }
    __syncthreads();
    const int tp = F.tid % (HT / 2), cq = F.tid / (HT / 2);
#pragma unroll
    for (int i = 0; i < CPT / 2; ++i) { const int cc = cq * (CPT / 2) + i;
        ((unsigned*)(UT + ((size_t)seq * HW + ct * 64 + cc) * SEQ + tt * HT))[tp] = pk2(tile[cc * (HT + 1) + 2 * tp], tile[cc * (HT + 1) + 2 * tp + 1]); }
}
DI void hyena_conv_unit(Frame& F, int c, const float* bias) {
    LAS v2f* d = (LAS v2f*)(F.lds + FFT_D_OFF); const LAS v2f* tw = (const LAS v2f*)(F.lds + FFT_TW_OFF);
    const v2f* KF = (const v2f*)(F.ws + WS_KF) + (size_t)c * FN;
    constexpr int NU = SEQ / NTHR > 0 ? SEQ / NTHR : 1; static_assert(FN % NTHR == 0, "fft size vs block");
    v4f kf[NMID];
#pragma unroll
    for (int k = 0; k < NMID; ++k) { const int g = F.tid + NTHR * k; if (g < FN / 2) kf[k] = ((const v4f*)KF)[g]; }
    const unsigned* U = (const unsigned*)((const bf16*)(F.ws + WS_UT) + (size_t)c * SEQ); unsigned* Y = (unsigned*)((bf16*)(F.ws + WS_XB) + (size_t)c * SEQ);
    constexpr int NP2 = SEQ / 2 / NTHR > 0 ? SEQ / 2 / NTHR : 1; constexpr size_t SQW = (size_t)HW * SEQ / 2;
    unsigned ua[NP2], ub[NP2], na[NP2], nb[NP2];
#pragma unroll
    for (int k = 0; k < NP2; ++k) { const int t2 = F.tid + NTHR * k; if (t2 < SEQ / 2) { na[k] = U[t2]; nb[k] = U[SQW + t2]; } }
    const float bs = bias[c], sc = 1.0f / (float)FN;
    __syncthreads();
    fft_load_tw(F);
#pragma unroll 1
    for (int p = 0; p < NPAIR; ++p) {
        if (p) __syncthreads();
#pragma unroll
        for (int k = 0; k < NP2; ++k) { const int t2 = F.tid + NTHR * k; ua[k] = na[k]; ub[k] = nb[k];
            if (t2 < SEQ / 2) { d[PH(2 * t2)] = (v2f){bflo(ua[k]), bflo(ub[k])}; d[PH(2 * t2 + 1)] = (v2f){bfhi(ua[k]), bfhi(ub[k])}; d[PH(SEQ + 2 * t2)] = (v2f){0.f, 0.f}; d[PH(SEQ + 2 * t2 + 1)] = (v2f){0.f, 0.f}; } }
        if (p + 1 < NPAIR) {
#pragma unroll
            for (int k = 0; k < NP2; ++k) { const int t2 = F.tid + NTHR * k; if (t2 < SEQ / 2) { na[k] = U[(size_t)(2 * p + 2) * SQW + t2]; nb[k] = U[(size_t)(2 * p + 3) * SQW + t2]; } } }
        __syncthreads();
        fft_dif_from<0>(d, tw, F.tid);
        fft_mid_conv(d, kf, F.tid);
        fft_idit_from<NP16 - 1>(d, tw, F.tid);
#pragma unroll
        for (int k = 0; k < NP2; ++k) { const int t2 = F.tid + NTHR * k; if (t2 < SEQ / 2) { const v2f y0 = d[PH(2 * t2)], y1 = d[PH(2 * t2 + 1)];
            Y[(size_t)(2 * p) * SQW + t2] = pk2(y0.x * sc + bflo(ua[k]) * bs, y1.x * sc + bfhi(ua[k]) * bs); Y[(size_t)(2 * p + 1) * SQW + t2] = pk2(y0.y * sc + bflo(ub[k]) * bs, y1.y * sc + bfhi(ub[k]) * bs); } }
    }
}
DI void hyena_post_unit(Frame& F, int unit, const float* cw, const float* cb) {
    constexpr int CT = HW / 64, TT = SEQ / HT, TPT = HT / 8, CG = NTHR / HT, CPT = 64 / CG;
    const int ct = unit % CT, tt = (unit / CT) % TT, seq = unit / (CT * TT);
    const bf16* PROJ = (const bf16*)(F.ws + WS_PROJ); const bf16* YT = (const bf16*)(F.ws + WS_XB); bf16* MIX = (bf16*)(F.ws + WS_MIX);
    LAS float* tile = (LAS float*)(F.lds + RING_OFF);
    LAS bf16* raw = (LAS bf16*)(F.lds + RING_OFF + 64 * (HT + 1) * 4);
    LAS bf16* otile = raw + (HT + 2) * 64;
    static_assert(64 * (HT + 1) * 4 + 2 * (HT + 2) * 64 * 2 + HT * 72 * 2 <= RING_BYTES, "hyena tile lds");
    const bf16* base = PROJ + (size_t)(seq * SEQ) * EIN_P + E_HY + ct * 64;
    __syncthreads();
    { const int tp = F.tid % (HT / 2), cq = F.tid / (HT / 2);
#pragma unroll
      for (int i = 0; i < CPT / 2; ++i) { const int cc = cq * (CPT / 2) + i; const unsigned w = ((const unsigned*)(YT + ((size_t)seq * HW + ct * 64 + cc) * SEQ + tt * HT))[tp];
          tile[cc * (HT + 1) + 2 * tp] = bflo(w); tile[cc * (HT + 1) + 2 * tp + 1] = bfhi(w); } }
    for (int q = F.tid; q < (HT + 2) * 8; q += NTHR) { const int row = q >> 3, c8 = q & 7, s = tt * HT - 1 + row;
        v4u v = {0u, 0u, 0u, 0u};
        if (s >= 0 && s < SEQ) v = *(const v4u*)(base + (size_t)s * EIN_P + c8 * 8);
        *(LAS v4u*)(raw + row * 64 + c8 * 8) = v; }
    const int cl = F.tid & 63, tq = F.tid >> 6, c = ct * 64 + cl;
    const float wa = cw[c], wb = cw[3 * HW + c], wc = cw[6 * HW + c], b0 = cb[c];
    __syncthreads();
#pragma unroll
    for (int i = 0; i < TPT; ++i) { const int r = tq * TPT + i + 1;
        const float x0 = bf2f(raw[(r - 1) * 64 + cl]) * wa + bf2f(raw[r * 64 + cl]) * wb + bf2f(raw[(r + 1) * 64 + cl]) * wc + b0;
        otile[(tq * TPT + i) * 72 + cl] = (bf16)f2bf(tile[cl * (HT + 1) + tq * TPT + i] * x0); }
    __syncthreads();
    for (int q = F.tid; q < HT * 8; q += NTHR) { const int row = q >> 3, c8 = q & 7;
        *(v4u*)(MIX + (size_t)(seq * SEQ + tt * HT + row) * EMIX + GV + ct * 64 + c8 * 8) = *(const LAS v4u*)(otile + row * 72 + c8 * 8); }
}

constexpr int G_LD = 264, G_LDS = 72;
DI void gla_prep_unit(Frame& F, int unit, const float* wg_f, const float* bg_f, const float* wg_b, const float* bg_b) {
    const int h = unit % GH, n = (unit / GH) % NCH, seq = unit / (GH * NCH);
    const bf16* PROJ = (const bf16*)(F.ws + WS_PROJ);
    LAS float* lr = (LAS float*)(F.lds + RING_OFF);
    LAS float* tot = lr + 64 * 16;
    LAS bf16* QDl = (LAS bf16*)(F.lds + RING_OFF + 8192);
    LAS bf16* KIl = QDl + 64 * G_LD;
    const int t0 = seq * SEQ + n * GCH, d = F.tid & 255, hf = F.tid >> 8, l15 = F.lane & 15, l4 = F.lane >> 4;
#pragma unroll 1
    for (int dir = 0; dir < 2; ++dir) {
        const float* wg = dir ? wg_b : wg_f; const float* bg = dir ? bg_b : bg_f;
        __syncthreads();
        if (F.tid < 128) { const int s = F.tid >> 1, r8 = (F.tid & 1) * 8; const v4u v = *(const v4u*)(PROJ + (size_t)(t0 + s) * EIN_P + (dir ? E_LRB : E_LRF) + r8);
#pragma unroll
            for (int j = 0; j < 4; ++j) { lr[s * 16 + r8 + 2 * j] = bflo(v[j]); lr[s * 16 + r8 + 2 * j + 1] = bfhi(v[j]); } }
#pragma unroll
        for (int i = 0; i < 4; ++i) { const int q = F.tid + NTHR * i, row = q >> 5, c16 = q & 31;
            *(LAS v4u*)(QDl + row * G_LD + c16 * 8) = *(const v4u*)(PROJ + (size_t)(t0 + row) * EIN_P + E_Q + h * 256 + c16 * 8);
            *(LAS v4u*)(KIl + row * G_LD + c16 * 8) = *(const v4u*)(PROJ + (size_t)(t0 + row) * EIN_P + E_K + h * 256 + c16 * 8); }
        float w[16];
#pragma unroll
        for (int r = 0; r < 16; ++r) w[r] = wg[(size_t)r * GQK + h * 256 + d];
        const float bgd = bg[h * 256 + d];
        __syncthreads();
        float bl[32]; float acc = 0.f;
#pragma unroll
        for (int i = 0; i < 32; ++i) { const int ii = 32 * hf + i, s = dir ? 63 - ii : ii;
            float lg = bgd;
#pragma unroll
            for (int r4 = 0; r4 < 4; ++r4) { const v4f lv = *(const LAS v4f*)(lr + s * 16 + r4 * 4); lg += lv.x * w[4 * r4] + lv.y * w[4 * r4 + 1] + lv.z * w[4 * r4 + 2] + lv.w * w[4 * r4 + 3]; }
            const float la = ((lg < 0.f ? lg : 0.f) - __logf(1.f + __expf(-fabsf(lg)))) * (1.0f / 16.0f);
            acc += la; bl[i] = acc; }
        tot[hf * 256 + d] = acc;
        __syncthreads();
        const float off = hf ? tot[d] : 0.f, btot = tot[d] + tot[256 + d];
        bf16* QD = (bf16*)(F.ws + WS_QD) + (size_t)dir * T * GQK;
#pragma unroll
        for (int i = 0; i < 32; ++i) { const int ii = 32 * hf + i, s = dir ? 63 - ii : ii;
            const float b = bl[i] + off, e = __expf(b), ei = frcp(e);
            const float q = bf2f(QDl[s * G_LD + d]) * 0.0625f * e;
            const float k = bf2f(KIl[s * G_LD + d]) * ei;
            QDl[s * G_LD + d] = (bf16)f2bf(q); KIl[s * G_LD + d] = (bf16)f2bf(k); }
        const size_t cu = (((size_t)dir * NSEQ + seq) * NCH + n) * GH + h;
        if (hf == 0) ((float*)(F.ws + WS_DEC))[cu * 256 + d] = __expf(btot);
        __syncthreads();
#pragma unroll
        for (int i = 0; i < 4; ++i) { const int q = F.tid + NTHR * i, row = q >> 5, c16 = q & 31;
            *(v4u*)(QD + (size_t)(t0 + row) * GQK + h * 256 + c16 * 8) = *(const LAS v4u*)(QDl + row * G_LD + c16 * 8); }
        { bf16* KIT = (bf16*)(F.ws + WS_KIT) + cu * (256 * 64);
#pragma unroll
          for (int i = 0; i < 4; ++i) { const int q = F.tid + NTHR * i, dd = q >> 3, s8 = (q & 7) * 8; v4u o;
#pragma unroll
              for (int j = 0; j < 4; ++j) o[j] = (unsigned)KIl[(s8 + 2 * j) * G_LD + dd] | ((unsigned)KIl[(s8 + 2 * j + 1) * G_LD + dd] << 16);
              *(v4u*)(KIT + dd * 64 + s8) = o; } }
        { const int mt = F.wave & 3, ntp = F.wave >> 2; v4f a0 = {0.f, 0.f, 0.f, 0.f}, a1 = a0;
#pragma unroll
          for (int ks = 0; ks < 8; ++ks) { const v8s af = ldfrag(QDl, mt * 16 + l15, G_LD, ks * 32 + l4 * 8);
              a0 = mma16(af, ldfrag(KIl, (2 * ntp) * 16 + l15, G_LD, ks * 32 + l4 * 8), a0);
              a1 = mma16(af, ldfrag(KIl, (2 * ntp + 1) * 16 + l15, G_LD, ks * 32 + l4 * 8), a1); }
          bf16* SC = (bf16*)(F.ws + WS_SC) + cu * (64 * 64);
#pragma unroll
          for (int j = 0; j < 4; ++j) { const int c = mt * 16 + 4 * l4 + j, sA = (2 * ntp) * 16 + l15, sB = sA + 16;
              const bool kA = dir ? (sA >= c) : (sA <= c), kB = dir ? (sB >= c) : (sB <= c);
              const float vA = kA ? a0[j] : 0.f, vB = kB ? a1[j] : 0.f, nA = lane_xor1(vA), nB = lane_xor1(vB);
              if (!(l15 & 1)) { *(unsigned*)(SC + c * 64 + sA) = pk2(vA, nA); *(unsigned*)(SC + c * 64 + sB) = pk2(vB, nB); } } }
    }
}

DI void gla_scan_unit(Frame& F, int unit) {
    constexpr int NES = GDV / 64;
    const int es = unit % NES, dir = (unit / NES) & 1, h = (unit / (2 * NES)) % GH, seq = unit / (2 * NES * GH);
    LAS bf16* QDl = (LAS bf16*)(F.lds + RING_OFF);
    LAS bf16* KITl = QDl + 64 * G_LD;
    LAS bf16* VTl = KITl + 256 * G_LDS;
    LAS bf16* SCl = VTl + 64 * G_LDS;
    LAS bf16* STl = SCl + 64 * G_LDS;
    static_assert((64 * G_LD * 2 + 256 * G_LDS + 2 * 64 * G_LDS) * 2 <= RING_BYTES, "gla scan lds");
    const bf16* PROJ = (const bf16*)(F.ws + WS_PROJ);
    const bf16* QD = (const bf16*)(F.ws + WS_QD) + (size_t)dir * T * GQK;
    bf16* O = (bf16*)(F.ws + WS_OF) + (size_t)dir * T * GV;
    const int l15 = F.lane & 15, l4 = F.lane >> 4, w = F.wave;
    __syncthreads();
    for (int i = F.tid; i < 64 * G_LD / 2; i += NTHR) ((LAS unsigned*)STl)[i] = 0u;
    v4f accS[4][2];
#pragma unroll
    for (int a = 0; a < 4; ++a)
#pragma unroll
        for (int b = 0; b < 2; ++b) accS[a][b] = (v4f){0.f, 0.f, 0.f, 0.f};
    v4u pq[4], pk[4], psc, pv; v4f pdec0, pdec1;
#define GLA_FETCH(cc) do { const int n_ = dir ? NCH - 1 - (cc) : (cc), t0_ = seq * SEQ + n_ * GCH; const size_t cu_ = (((size_t)dir * NSEQ + seq) * NCH + n_) * GH + h; \
        _Pragma("unroll") for (int i = 0; i < 4; ++i) { const int q = F.tid + NTHR * i; pq[i] = *(const v4u*)(QD + (size_t)(t0_ + (q >> 5)) * GQK + h * 256 + (q & 31) * 8); \
            pk[i] = *(const v4u*)((const bf16*)(F.ws + WS_KIT) + cu_ * (256 * 64) + q * 8); } \
        psc = *(const v4u*)((const bf16*)(F.ws + WS_SC) + cu_ * (64 * 64) + F.tid * 8); \
        pv = *(const v4u*)(PROJ + (size_t)(t0_ + (F.tid & 63)) * EIN_P + E_V + h * GDV + es * 64 + (F.tid >> 6) * 8); \
        pdec0 = *(const v4f*)((const float*)(F.ws + WS_DEC) + cu_ * 256 + 32 * w + 4 * l4); pdec1 = *(const v4f*)((const float*)(F.ws + WS_DEC) + cu_ * 256 + 32 * w + 16 + 4 * l4); } while (0)
    GLA_FETCH(0);
#pragma unroll 1
    for (int ci = 0; ci < NCH; ++ci) {
        const int n = dir ? NCH - 1 - ci : ci, t0 = seq * SEQ + n * GCH;
#pragma unroll
        for (int i = 0; i < 4; ++i) { const int q = F.tid + NTHR * i;
            *(LAS v4u*)(QDl + (q >> 5) * G_LD + (q & 31) * 8) = pq[i]; *(LAS v4u*)(KITl + (q >> 3) * G_LDS + (q & 7) * 8) = pk[i]; }
        *(LAS v4u*)(SCl + (F.tid >> 3) * G_LDS + (F.tid & 7) * 8) = psc;
        { const int s = F.tid & 63, e8 = F.tid >> 6;
#pragma unroll
          for (int j = 0; j < 4; ++j) { VTl[(e8 * 8 + 2 * j) * G_LDS + s] = (bf16)(pv[j] & 0xffffu); VTl[(e8 * 8 + 2 * j + 1) * G_LDS + s] = (bf16)(pv[j] >> 16); } }
        const v4f dec0 = pdec0, dec1 = pdec1;
        __syncthreads();
        if (ci + 1 < NCH) GLA_FETCH(ci + 1);
        { const int mt = w & 3, ntp = w >> 2; v4f o0 = {0.f, 0.f, 0.f, 0.f}, o1 = o0;
#pragma unroll
          for (int ks = 0; ks < 2; ++ks) { const v8s af = ldfrag(SCl, mt * 16 + l15, G_LDS, ks * 32 + l4 * 8);
              o0 = mma16(af, ldfrag(VTl, (2 * ntp) * 16 + l15, G_LDS, ks * 32 + l4 * 8), o0);
              o1 = mma16(af, ldfrag(VTl, (2 * ntp + 1) * 16 + l15, G_LDS, ks * 32 + l4 * 8), o1); }
#pragma unroll
          for (int ks = 0; ks < 8; ++ks) { const v8s af = ldfrag(QDl, mt * 16 + l15, G_LD, ks * 32 + l4 * 8);
              o0 = mma16(af, ldfrag(STl, (2 * ntp) * 16 + l15, G_LD, ks * 32 + l4 * 8), o0);
              o1 = mma16(af, ldfrag(STl, (2 * ntp + 1) * 16 + l15, G_LD, ks * 32 + l4 * 8), o1); }
#pragma unroll
          for (int j = 0; j < 4; ++j) { bf16* op = O + (size_t)(t0 + mt * 16 + 4 * l4 + j) * GV + h * GDV + es * 64 + (2 * ntp) * 16 + l15;
              const float n0 = lane_xor1(o0[j]), n1 = lane_xor1(o1[j]);
              if (!(l15 & 1)) { *(unsigned*)op = pk2(o0[j], n0); *(unsigned*)(op + 16) = pk2(o1[j], n1); } } }
#pragma unroll
        for (int ks = 0; ks < 2; ++ks) {
            const v8s b0 = ldfrag(KITl, 32 * w + l15, G_LDS, ks * 32 + l4 * 8), b1 = ldfrag(KITl, 32 * w + 16 + l15, G_LDS, ks * 32 + l4 * 8);
#pragma unroll
            for (int et = 0; et < 4; ++et) { const v8s af = ldfrag(VTl, et * 16 + l15, G_LDS, ks * 32 + l4 * 8);
                accS[et][0] = mma16(b0, af, accS[et][0]); accS[et][1] = mma16(b1, af, accS[et][1]); } }
#pragma unroll
        for (int et = 0; et < 4; ++et) { accS[et][0] = accS[et][0] * dec0; accS[et][1] = accS[et][1] * dec1; }
        __syncthreads();
#pragma unroll
        for (int et = 0; et < 4; ++et) {
            *(LAS v2u*)(STl + (et * 16 + l15) * G_LD + 32 * w + 4 * l4) = (v2u){pk2(accS[et][0][0], accS[et][0][1]), pk2(accS[et][0][2], accS[et][0][3])};
            *(LAS v2u*)(STl + (et * 16 + l15) * G_LD + 32 * w + 16 + 4 * l4) = (v2u){pk2(accS[et][1][0], accS[et][1][1]), pk2(accS[et][1][2], accS[et][1][3])}; }
    }
}
DI void gla_post(Frame& F, const float* gn) {
    const bf16* PROJ = (const bf16*)(F.ws + WS_PROJ); bf16* MIX = (bf16*)(F.ws + WS_MIX);
    const bf16* OFp = (const bf16*)(F.ws + WS_OF); const bf16* OBp = OFp + (size_t)T * GV;
    const int gw = F.vcu * NWAVES + F.wave, NGW = F.G * NWAVES;
    const v4f g0 = *(const v4f*)(gn + F.lane * 8), g1 = *(const v4f*)(gn + F.lane * 8 + 4);
    static_assert((T * GH) % 2 == 0, "gla_post pairs");
#pragma unroll 1
    for (int u0 = 2 * gw; u0 < T * GH; u0 += 2 * NGW) {
        v4f o0[2], o1[2]; v4u og[2]; size_t mo[2];
#pragma unroll
        for (int r = 0; r < 2; ++r) { const int u = u0 + r, t = u / GH, h = u % GH; const size_t off = (size_t)t * GV + h * GDV + F.lane * 8;
            const v4u af_ = *(const v4u*)(OFp + off), ab_ = *(const v4u*)(OBp + off);
            const v4f a0 = {bflo(af_.x), bfhi(af_.x), bflo(af_.y), bfhi(af_.y)}, a1 = {bflo(af_.z), bfhi(af_.z), bflo(af_.w), bfhi(af_.w)}, b0 = {bflo(ab_.x), bfhi(ab_.x), bflo(ab_.y), bfhi(ab_.y)}, b1 = {bflo(ab_.z), bfhi(ab_.z), bflo(ab_.w), bfhi(ab_.w)};
            o0[r] = a0 + b0; o1[r] = a1 + b1; og[r] = *(const v4u*)(PROJ + (size_t)t * EIN_P + E_OG + h * GDV + F.lane * 8); mo[r] = (size_t)t * EMIX + h * GDV + F.lane * 8; }
        float ss[2];
#pragma unroll
        for (int r = 0; r < 2; ++r) ss[r] = (o0[r].x * o0[r].x + o0[r].y * o0[r].y) + (o0[r].z * o0[r].z + o0[r].w * o0[r].w) + (o1[r].x * o1[r].x + o1[r].y * o1[r].y) + (o1[r].z * o1[r].z + o1[r].w * o1[r].w);
#pragma unroll
        for (int o = 1; o < 64; o <<= 1) { const float ta = __shfl_xor(ss[0], o), tb = __shfl_xor(ss[1], o); ss[0] += ta; ss[1] += tb; }
#pragma unroll
        for (int r = 0; r < 2; ++r) { const float rr = frsq(ss[r] * (1.0f / GDV) + RMS_EPS); v4u o;
            o.x = pk2(o0[r].x * rr * g0.x * siluf_(bflo(og[r].x)), o0[r].y * rr * g0.y * siluf_(bfhi(og[r].x)));
            o.y = pk2(o0[r].z * rr * g0.z * siluf_(bflo(og[r].y)), o0[r].w * rr * g0.w * siluf_(bfhi(og[r].y)));
            o.z = pk2(o1[r].x * rr * g1.x * siluf_(bflo(og[r].z)), o1[r].y * rr * g1.y * siluf_(bfhi(og[r].z)));
            o.w = pk2(o1[r].z * rr * g1.z * siluf_(bflo(og[r].w)), o1[r].w * rr * g1.w * siluf_(bfhi(og[r].w)));
            *(v4u*)(MIX + mo[r]) = o; }
    }
}

struct EvenW { const float *wg_f, *bg_f, *wg_b, *bg_b, *gnorm, *hcw, *hcb, *w3, *hbias; };
DI void even_mixer_a(Frame& F, const EvenW& W) {
    constexpr int NG1 = NSEQ * NCH * GH, NHF = HW, NH1 = NSEQ * (SEQ / HT) * (HW / 64);
    for (int u = F.vcu; u < NHF; u += F.G) hyena_filter_unit(F, u, W.w3);
    for (int u = F.vcu; u < NG1; u += F.G) gla_prep_unit(F, u, W.wg_f, W.bg_f, W.wg_b, W.bg_b);
    for (int u = F.vcu; u < NH1; u += F.G) hyena_prep_unit(F, u, W.hcw, W.hcb);
}
DI void even_mixer_b(Frame& F, const EvenW& W) {
    constexpr int NG2 = NSEQ * GH * 2 * (GDV / 64), NH2 = HW;
    for (int u = F.vcu; u < NG2; u += F.G) gla_scan_unit(F, u);
    constexpr int H2_SKEW = NPAIR >= 3 ? 4 : 4;
    const int nheavy = NG2 > F.G ? (NG2 - F.G < F.G ? NG2 - F.G : F.G) : 0, nlight = F.G - nheavy;
    for (int s = 0;; ++s) {
        int u;
        if (s < H2_SKEW) { if (F.vcu < nheavy) continue; u = s * nlight + (F.vcu - nheavy); }
        else u = H2_SKEW * nlight + (s - H2_SKEW) * F.G + F.vcu;
        if (u >= NH2) break;
        hyena_conv_unit(F, u, W.hbias);
    }
}
DI void even_mixer_c(Frame& F, const EvenW& W) {
    constexpr int NH3 = NSEQ * (SEQ / HT) * (HW / 64);
    gla_post(F, W.gnorm);
    for (int u = F.vcu; u < NH3; u += F.G) hyena_post_unit(F, u, W.hcw, W.hcb);
}
constexpr int SCH = 64, NSC = SEQ / SCH;
constexpr int NSEG = SEQ / 64;
constexpr size_t WS_XC = WS_SCR,                 SZ_XC = alup((size_t)T * SCD * 2);
constexpr size_t WS_DTV = WS_XC + SZ_XC,         SZ_DTV = alup((size_t)2 * T * SNH * 4);
constexpr size_t WS_ACV = WS_DTV + SZ_DTV,       SZ_ACV = SZ_DTV;
constexpr size_t WS_YS = WS_ACV + SZ_ACV,        SZ_YS = alup((size_t)2 * T * SIN * 4);
constexpr size_t WS_LA = WS_YS + SZ_YS,          SZ_LA = alup((size_t)2 * T * LW * 2);
constexpr size_t WS_LB = WS_LA + SZ_LA,          SZ_LB = SZ_LA;
constexpr size_t WS_SEGA = WS_LB + SZ_LB,        SZ_SEGA = alup((size_t)2 * NSEQ * NSEG * LW * 4);
constexpr size_t WS_SEGH = WS_SEGA + SZ_SEGA,    SZ_SEGH = SZ_SEGA;
constexpr size_t WS_SEGC = WS_SEGH + SZ_SEGH,    SZ_SEGC = SZ_SEGA;
constexpr size_t WS_END_ODD = WS_SEGC + SZ_SEGC;

struct OddW { const float *scw, *scb, *dtb, *alog, *dsk, *snorm, *lcw, *lcb, *wa, *ba, *wx, *bx, *lam; };

DI void lru_pro(Frame& F, const float* wa, const float* wx) {
    bf16* WLT = (bf16*)(F.ws + WS_WLT);
    const int n = 2 * LNB * 2 * 128 * 128;
    for (int i = 2 * (F.vcu * NTHR + F.tid); i < n; i += 2 * F.G * NTHR) {
        const int c = i & 127, d = (i >> 7) & 127, m = (i >> 14) & 1, k = (i >> 15) % LNB, dir = i / (32768 * LNB);
        const float* W = m ? wx : wa;
        *(unsigned*)(WLT + i) = pk2(W[(((size_t)dir * LNB + k) * 128 + c) * 128 + d], W[(((size_t)dir * LNB + k) * 128 + c + 1) * 128 + d]);
    }
}

DI void ssd_prep(Frame& F, const OddW& W) {
    const bf16* PROJ = (const bf16*)(F.ws + WS_PROJ); bf16* XC = (bf16*)(F.ws + WS_XC);
    constexpr int VC = SCD / 8, TB = 16;
    const int gt = F.vcu * NTHR + F.tid, NT = F.G * NTHR, ngrp = NT / VC;
    if (gt < ngrp * VC) {
        const int vc = gt % VC, grp = gt / VC, c0 = vc * 8;
        float w[4][8], bb[8];
#pragma unroll
        for (int e = 0; e < 8; ++e) {
#pragma unroll
            for (int j = 0; j < 4; ++j) w[j][e] = W.scw[(size_t)j * SCD + c0 + e];
            bb[e] = W.scb[c0 + e]; }
        const v4u z4 = {0u, 0u, 0u, 0u};
#pragma unroll 1
        for (int tb = grp; tb < T / TB; tb += ngrp) {
            const int t0 = tb * TB, s0 = t0 % SEQ;
            const bf16* hp = PROJ + (size_t)t0 * OIN_P + O_XBC + c0;
            v4u xm = s0 > 0 ? *(const v4u*)(hp - OIN_P) : z4, x0 = *(const v4u*)hp, x1 = (s0 + 1 < SEQ) ? *(const v4u*)(hp + OIN_P) : z4;
#pragma unroll 8
            for (int i = 0; i < TB; ++i) {
                const v4u x2 = (s0 + i + 2 < SEQ) ? *(const v4u*)(hp + (size_t)(i + 2) * OIN_P) : z4;
                v4u o;
#pragma unroll
                for (int q = 0; q < 4; ++q) {
                    const float a0 = bflo(xm[q]) * w[0][2 * q] + bflo(x0[q]) * w[1][2 * q] + bflo(x1[q]) * w[2][2 * q] + bflo(x2[q]) * w[3][2 * q] + bb[2 * q];
                    const float a1 = bfhi(xm[q]) * w[0][2 * q + 1] + bfhi(x0[q]) * w[1][2 * q + 1] + bfhi(x1[q]) * w[2][2 * q + 1] + bfhi(x2[q]) * w[3][2 * q + 1] + bb[2 * q + 1];
                    o[q] = pk2(siluf_(a0), siluf_(a1)); }
                *(v4u*)(XC + (size_t)(t0 + i) * SCD + c0) = o;
                xm = x0; x0 = x1; x1 = x2;
            }
        }
    }
    float* DTV = (float*)(F.ws + WS_DTV); float* ACV = (float*)(F.ws + WS_ACV);
    constexpr int NU = NSEQ * NSC * 2 * SNH;
#pragma unroll 1
    for (int u = gt; u < NU; u += NT) {
        const int hd = u % SNH, dir = (u / SNH) & 1, n = (u / (2 * SNH)) % NSC, seq = u / (2 * SNH * NSC);
        const float bias = W.dtb[dir * SNH + hd], A = -__expf(W.alog[dir * SNH + hd]);
        const int t0 = seq * SEQ + n * SCH; float acc = 0.f;
#pragma unroll 16
        for (int i = 0; i < SCH; ++i) { const int t = t0 + (dir ? SCH - 1 - i : i);
            const float dt = softplusf_(bf2f(PROJ[(size_t)t * OIN_P + O_DT + dir * SNH + hd]) + bias);
            acc += dt * A;
            DTV[((size_t)dir * T + t) * SNH + hd] = dt; ACV[((size_t)dir * T + t) * SNH + hd] = acc; }
    }
}

constexpr int S_LDN = 136, S_LDS = 72;
DI void ssd_scan_unit(Frame& F, int unit) {
    const int hd = unit % SNH, dir = (unit / SNH) & 1, seq = unit / (2 * SNH), g = hd / SHG;
    LAS bf16* Cl = (LAS bf16*)(F.lds + RING_OFF);
    LAS bf16* Bl = Cl + 64 * S_LDN;
    LAS bf16* BTw = Bl + 64 * S_LDN;
    LAS bf16* XTl = BTw + 128 * S_LDS;
    LAS bf16* Ml = XTl + 64 * S_LDS;
    LAS bf16* STl = Ml + 64 * S_LDS;
    LAS float* acl = (LAS float*)(STl + 64 * S_LDN);
    const bf16* XC = (const bf16*)(F.ws + WS_XC);
    const float* DTV = (const float*)(F.ws + WS_DTV) + (size_t)dir * T * SNH; const float* ACV = (const float*)(F.ws + WS_ACV) + (size_t)dir * T * SNH;
    bf16* Y = (bf16*)(F.ws + WS_YS) + (size_t)dir * T * SIN;
    const int l15 = F.lane & 15, l4 = F.lane >> 4, w = F.wave;
    __syncthreads();
    for (int i = F.tid; i < 64 * S_LDN / 2; i += NTHR) ((LAS unsigned*)STl)[i] = 0u;
    v4f accS[4];
#pragma unroll
    for (int a = 0; a < 4; ++a) accS[a] = (v4f){0.f, 0.f, 0.f, 0.f};
    v4u pc[2], pb[2], px; float pac, pdt, pend;
#define SSD_FETCH(cc) do { const int n_ = dir ? NSC - 1 - (cc) : (cc), t0_ = seq * SEQ + n_ * SCH; const int row = F.tid & 63; \
        _Pragma("unroll") for (int i = 0; i < 2; ++i) { const int c16 = (F.tid >> 6) + 8 * i; \
            pc[i] = *(const v4u*)(XC + (size_t)(t0_ + row) * SCD + SIN + SBC + g * SN + c16 * 8); pb[i] = *(const v4u*)(XC + (size_t)(t0_ + row) * SCD + SIN + g * SN + c16 * 8); } \
        px = *(const v4u*)(XC + (size_t)(t0_ + row) * SCD + hd * SP + (F.tid >> 6) * 8); \
        pac = ACV[(size_t)(t0_ + row) * SNH + hd]; pdt = DTV[(size_t)(t0_ + row) * SNH + hd]; pend = ACV[(size_t)(t0_ + (dir ? 0 : SCH - 1)) * SNH + hd]; } while (0)
    SSD_FETCH(0);
#pragma unroll 1
    for (int ci = 0; ci < NSC; ++ci) {
        const int n = dir ? NSC - 1 - ci : ci, t0 = seq * SEQ + n * SCH;
        const float ac_end = pend;
        { const int row = F.tid & 63; const float ws = __expf(ac_end - pac);
#pragma unroll
          for (int i = 0; i < 2; ++i) { const int c16 = (F.tid >> 6) + 8 * i;
              *(LAS v4u*)(Cl + row * S_LDN + c16 * 8) = pc[i]; *(LAS v4u*)(Bl + row * S_LDN + c16 * 8) = pb[i];
#pragma unroll
              for (int j = 0; j < 4; ++j) { BTw[(c16 * 8 + 2 * j) * S_LDS + row] = (bf16)f2bf(bflo(pb[i][j]) * ws); BTw[(c16 * 8 + 2 * j + 1) * S_LDS + row] = (bf16)f2bf(bfhi(pb[i][j]) * ws); } }
          const int p8 = F.tid >> 6;
#pragma unroll
          for (int j = 0; j < 4; ++j) { XTl[(p8 * 8 + 2 * j) * S_LDS + row] = (bf16)f2bf(bflo(px[j]) * pdt); XTl[(p8 * 8 + 2 * j + 1) * S_LDS + row] = (bf16)f2bf(bfhi(px[j]) * pdt); }
          if (F.tid < 64) acl[row] = pac; }
        __syncthreads();
        if (ci + 1 < NSC) SSD_FETCH(ci + 1);
        const int mt = w & 3, ntp = w >> 2;
        { v4f a0 = {0.f, 0.f, 0.f, 0.f}, a1 = a0;
#pragma unroll
          for (int ks = 0; ks < 4; ++ks) { const v8s bfg = ldfrag(Cl, mt * 16 + l15, S_LDN, ks * 32 + l4 * 8);
              a0 = mma16(ldfrag(Bl, (2 * ntp) * 16 + l15, S_LDN, ks * 32 + l4 * 8), bfg, a0);
              a1 = mma16(ldfrag(Bl, (2 * ntp + 1) * 16 + l15, S_LDN, ks * 32 + l4 * 8), bfg, a1); }
          const int l = mt * 16 + l15, sA = (2 * ntp) * 16 + 4 * l4, sB = sA + 16; const float al = acl[l];
          const v4f acA = *(const LAS v4f*)(acl + sA), acB = *(const LAS v4f*)(acl + sB);
          float mA[4], mB[4];
#pragma unroll
          for (int j = 0; j < 4; ++j) { const bool kA = dir ? (sA + j >= l) : (sA + j <= l), kB = dir ? (sB + j >= l) : (sB + j <= l);
              mA[j] = kA ? a0[j] * __expf(al - acA[j]) : 0.f; mB[j] = kB ? a1[j] * __expf(al - acB[j]) : 0.f; }
          *(LAS v2u*)(Ml + l * S_LDS + sA) = (v2u){pk2(mA[0], mA[1]), pk2(mA[2], mA[3])}; *(LAS v2u*)(Ml + l * S_LDS + sB) = (v2u){pk2(mB[0], mB[1]), pk2(mB[2], mB[3])}; }
        v4f y0 = {0.f, 0.f, 0.f, 0.f}, y1 = y0;
#pragma unroll
        for (int ks = 0; ks < 4; ++ks) { const v8s af = ldfrag(Cl, mt * 16 + l15, S_LDN, ks * 32 + l4 * 8);
            y0 = mma16(af, ldfrag(STl, (2 * ntp) * 16 + l15, S_LDN, ks * 32 + l4 * 8), y0);
            y1 = mma16(af, ldfrag(STl, (2 * ntp + 1) * 16 + l15, S_LDN, ks * 32 + l4 * 8), y1); }
#pragma unroll
        for (int j = 0; j < 4; ++j) { const float sc = __expf(acl[mt * 16 + 4 * l4 + j]); y0[j] *= sc; y1[j] *= sc; }
        __syncthreads();
#pragma unroll
        for (int ks = 0; ks < 2; ++ks) { const v8s af = ldfrag(Ml, mt * 16 + l15, S_LDS, ks * 32 + l4 * 8);
            y0 = mma16(af, ldfrag(XTl, (2 * ntp) * 16 + l15, S_LDS, ks * 32 + l4 * 8), y0);
            y1 = mma16(af, ldfrag(XTl, (2 * ntp + 1) * 16 + l15, S_LDS, ks * 32 + l4 * 8), y1); }
#pragma unroll
        for (int j = 0; j < 4; ++j) { bf16* yp = Y + (size_t)(t0 + mt * 16 + 4 * l4 + j) * SIN + hd * SP + (2 * ntp) * 16 + l15; const float n0 = lane_xor1(y0[j]), n1 = lane_xor1(y1[j]);
            if (!(l15 & 1)) { *(unsigned*)yp = pk2(y0[j], n0); *(unsigned*)(yp + 16) = pk2(y1[j], n1); } }
        { const float dec = __expf(ac_end);
#pragma unroll
          for (int pt = 0; pt < 4; ++pt) accS[pt] = accS[pt] * dec;
#pragma unroll
          for (int ks = 0; ks < 2; ++ks) { const v8s bf = ldfrag(BTw, 16 * w + l15, S_LDS, ks * 32 + l4 * 8);
#pragma unroll
              for (int pt = 0; pt < 4; ++pt) accS[pt] = mma16(bf, ldfrag(XTl, pt * 16 + l15, S_LDS, ks * 32 + l4 * 8), accS[pt]); } }
        __syncthreads();
#pragma unroll
        for (int pt = 0; pt < 4; ++pt) *(LAS v2u*)(STl + (pt * 16 + l15) * S_LDN + 16 * w + 4 * l4) = (v2u){pk2(accS[pt][0], accS[pt][1]), pk2(accS[pt][2], accS[pt][3])};
    }
}
DI void ssd_post(Frame& F, const OddW& W) {
    const bf16* PROJ = (const bf16*)(F.ws + WS_PROJ); const bf16* XC = (const bf16*)(F.ws + WS_XC); bf16* MIX = (bf16*)(F.ws + WS_MIX);
    const bf16* YF = (const bf16*)(F.ws + WS_YS); const bf16* YB = YF + (size_t)T * SIN;
    constexpr int GW = SIN / SG;
    static_assert(GW == 512 && (T * SG) % 2 == 0, "ssd group width, row pairs");
    const int gw = F.vcu * NWAVES + F.wave, NGW = F.G * NWAVES;
#pragma unroll 1
    for (int u0 = 2 * gw; u0 < T * SG; u0 += 2 * NGW) {
        float y[2][8]; float ss[2]; int chs[2]; size_t mo[2];
#pragma unroll
        for (int r = 0; r < 2; ++r) { const int u = u0 + r, t = u / SG, g = u % SG; const int ch = g * GW + F.lane * 8, hd = ch / SP;
            const float ds = W.dsk[hd] + W.dsk[SNH + hd];
            const size_t off = (size_t)t * SIN + ch;
            const v4u af_ = *(const v4u*)(YF + off), ab_ = *(const v4u*)(YB + off);
            const v4f a0 = {bflo(af_.x), bfhi(af_.x), bflo(af_.y), bfhi(af_.y)}, a1 = {bflo(af_.z), bfhi(af_.z), bflo(af_.w), bfhi(af_.w)}, b0 = {bflo(ab_.x), bfhi(ab_.x), bflo(ab_.y), bfhi(ab_.y)}, b1 = {bflo(ab_.z), bfhi(ab_.z), bflo(ab_.w), bfhi(ab_.w)};
            const v4u xs = *(const v4u*)(XC + (size_t)t * SCD + ch), zz = *(const v4u*)(PROJ + (size_t)t * OIN_P + O_Z + ch);
            y[r][0] = (a0.x + b0.x + bflo(xs.x) * ds) * siluf_(bflo(zz.x)); y[r][1] = (a0.y + b0.y + bfhi(xs.x) * ds) * siluf_(bfhi(zz.x));
            y[r][2] = (a0.z + b0.z + bflo(xs.y) * ds) * siluf_(bflo(zz.y)); y[r][3] = (a0.w + b0.w + bfhi(xs.y) * ds) * siluf_(bfhi(zz.y));
            y[r][4] = (a1.x + b1.x + bflo(xs.z) * ds) * siluf_(bflo(zz.z)); y[r][5] = (a1.y + b1.y + bfhi(xs.z) * ds) * siluf_(bfhi(zz.z));
            y[r][6] = (a1.z + b1.z + bflo(xs.w) * ds) * siluf_(bflo(zz.w)); y[r][7] = (a1.w + b1.w + bfhi(xs.w) * ds) * siluf_(bfhi(zz.w));
            float s = 0.f;
#pragma unroll
            for (int e = 0; e < 8; ++e) s += y[r][e] * y[r][e];
            ss[r] = s; chs[r] = ch; mo[r] = (size_t)t * OMIX + ch; }
#pragma unroll
        for (int o = 1; o < 64; o <<= 1) { const float ta = __shfl_xor(ss[0], o), tb = __shfl_xor(ss[1], o); ss[0] += ta; ss[1] += tb; }
#pragma unroll
        for (int r = 0; r < 2; ++r) { const float rr = frsq(ss[r] * (1.0f / GW) + RMS_EPS);
            const v4f g0 = *(const v4f*)(W.snorm + chs[r]), g1 = *(const v4f*)(W.snorm + chs[r] + 4);
            v4u o; o.x = pk2(y[r][0] * rr * g0.x, y[r][1] * rr * g0.y); o.y = pk2(y[r][2] * rr * g0.z, y[r][3] * rr * g0.w); o.z = pk2(y[r][4] * rr * g1.x, y[r][5] * rr * g1.y); o.w = pk2(y[r][6] * rr * g1.z, y[r][7] * rr * g1.w);
            *(v4u*)(MIX + mo[r]) = o; }
    }
}

DI float gelu_tanh(float x) { const float y = 0.7978845608028654f * (x + 0.044715f * x * x * x); const float e = __expf(2.f * y); return 0.5f * x * (2.f - 2.f * frcp(e + 1.f)); }
DI void lru_gate_unit(Frame& F, int unit, const OddW& W) {
    const int k = unit % LNB, seg = (unit / LNB) % NSEG, seq = unit / (LNB * NSEG);
    constexpr int TLD = 72;
    LAS bf16* XCl = (LAS bf16*)(F.lds + RING_OFF);
    LAS bf16* LT = XCl + 64 * S_LDN;
    LAS bf16* rawl = LT;
    LAS float* sub = (LAS float*)(LT + 4 * 128 * TLD);
    static_assert((64 * S_LDN + 4 * 128 * TLD) * 2 + 2 * 4 * 128 * 2 * 4 <= RING_BYTES && 67 * 128 <= 4 * 128 * TLD, "lru lds");
    const bf16* PROJ = (const bf16*)(F.ws + WS_PROJ);
    const int t0 = seq * SEQ + seg * 64, s0 = seg * 64;
    const int l15 = F.lane & 15, l4 = F.lane >> 4, w = F.wave;
    __syncthreads();
    for (int q = F.tid; q < 67 * 16; q += NTHR) { const int row = q >> 4, c8 = q & 15, s = s0 - 1 + row;
        v4u v = {0u, 0u, 0u, 0u};
        if (s >= 0 && s < SEQ) v = *(const v4u*)(PROJ + (size_t)(seq * SEQ + s) * OIN_P + O_R + k * 128 + c8 * 8);
        *(LAS v4u*)(rawl + row * 128 + c8 * 8) = v; }
    __syncthreads();
    {   const int cp = F.tid & 63, tq = F.tid >> 6, c = k * 128 + 2 * cp;
        const v2f w0 = *(const v2f*)(W.lcw + c), w1 = *(const v2f*)(W.lcw + LW + c), w2 = *(const v2f*)(W.lcw + 2 * LW + c), w3 = *(const v2f*)(W.lcw + 3 * LW + c), b = *(const v2f*)(W.lcb + c);
        const LAS unsigned* r32 = (const LAS unsigned*)rawl;
        unsigned xm = r32[(tq * 8) * 64 + cp], x0 = r32[(tq * 8 + 1) * 64 + cp], x1 = r32[(tq * 8 + 2) * 64 + cp];
        unsigned outv[8];
#pragma unroll
        for (int i = 0; i < 8; ++i) { const int tl = tq * 8 + i;
            const unsigned x2 = r32[(tl + 3) * 64 + cp];
            outv[i] = pk2(bflo(xm) * w0.x + bflo(x0) * w1.x + bflo(x1) * w2.x + bflo(x2) * w3.x + b.x, bfhi(xm) * w0.y + bfhi(x0) * w1.y + bfhi(x1) * w2.y + bfhi(x2) * w3.y + b.y);
            xm = x0; x0 = x1; x1 = x2; }
#pragma unroll
        for (int i = 0; i < 8; ++i) ((LAS unsigned*)XCl)[(tq * 8 + i) * (S_LDN / 2) + cp] = outv[i]; }
    __syncthreads();
#pragma unroll 1
    for (int dir = 0; dir < 2; ++dir) {
        const bf16* WA = (const bf16*)(F.ws + WS_WLT) + (((size_t)dir * LNB + k) * 2 + 0) * 16384; const bf16* WX = WA + 16384;
        v4f ar[4], ai[4];
#pragma unroll
        for (int m = 0; m < 4; ++m) { ar[m] = (v4f){0.f, 0.f, 0.f, 0.f}; ai[m] = ar[m]; }
#pragma unroll
        for (int ks = 0; ks < 4; ++ks) { const v8s ba = *(const v8s*)(WA + (16 * w + l15) * 128 + ks * 32 + l4 * 8), bx = *(const v8s*)(WX + (16 * w + l15) * 128 + ks * 32 + l4 * 8);
#pragma unroll
            for (int m = 0; m < 4; ++m) { const v8s af = ldfrag(XCl, m * 16 + l15, S_LDN, ks * 32 + l4 * 8); ar[m] = mma16(af, ba, ar[m]); ai[m] = mma16(af, bx, ai[m]); } }
        const int d = 16 * w + l15, c = k * 128 + d;
        const float bav = W.ba[dir * LW + c], bxv = W.bx[dir * LW + c], sp = softplusf_(-W.lam[dir * LW + c]);
        LAS bf16* LTa = LT + (dir * 2 + 0) * 128 * TLD + d * TLD; LAS bf16* LTb = LT + (dir * 2 + 1) * 128 * TLD + d * TLD;
#pragma unroll
        for (int m = 0; m < 4; ++m) { float la[4], bb[4];
#pragma unroll
            for (int j = 0; j < 4; ++j) { const int tl = m * 16 + 4 * l4 + j;
                const float r = sigmoidf_(ar[m][j] + bav), ii = sigmoidf_(ai[m][j] + bxv);
                la[j] = -8.0f * r * sp; bb[j] = fsqrt_(1.0f - __expf(2.0f * la[j])) * ii * bf2f(XCl[tl * S_LDN + d]); }
            *(LAS v2u*)(LTa + m * 16 + 4 * l4) = (v2u){pk2(la[0], la[1]), pk2(la[2], la[3])}; *(LAS v2u*)(LTb + m * 16 + 4 * l4) = (v2u){pk2(bb[0], bb[1]), pk2(bb[2], bb[3])}; }
    }
    __syncthreads();
#pragma unroll
    for (int i = 0; i < 8; ++i) { const int q = F.tid + NTHR * i, da = q >> 10, dd = (q >> 3) & 127, t8 = (q & 7) * 8, dir = da >> 1, arr = da & 1;
        bf16* G = (bf16*)(F.ws + (arr ? WS_LB : WS_LA)) + ((((size_t)dir * NSEQ + seq) * NSEG + seg) * LW + k * 128) * 64;
        *(v4u*)(G + dd * 64 + t8) = *(const LAS v4u*)(LT + da * 128 * TLD + dd * TLD + t8); }
    {   const int ch = F.tid & 127, q = F.tid >> 7;
#pragma unroll
        for (int dir = 0; dir < 2; ++dir) { const int blk = dir ? 3 - q : q;
            const LAS v4u* pa = (const LAS v4u*)(LT + (dir * 2 + 0) * 128 * TLD + ch * TLD + blk * 16); const LAS v4u* pb = (const LAS v4u*)(LT + (dir * 2 + 1) * 128 * TLD + ch * TLD + blk * 16);
            const v4u a0 = pa[0], a1 = pa[1], b0 = pb[0], b1 = pb[1]; float sa = 0.f, h = 0.f;
#pragma unroll
            for (int i = 0; i < 16; ++i) { const int e = dir ? 15 - i : i; const unsigned wa_ = e < 8 ? a0[e >> 1] : a1[(e - 8) >> 1], wb_ = e < 8 ? b0[e >> 1] : b1[(e - 8) >> 1];
                const float la = (e & 1) ? bfhi(wa_) : bflo(wa_), bb = (e & 1) ? bfhi(wb_) : bflo(wb_); sa += la; h = __expf(la) * h + bb; }
            sub[((dir * 4 + q) * 128 + ch) * 2] = sa; sub[((dir * 4 + q) * 128 + ch) * 2 + 1] = h; } }
    __syncthreads();
    if (F.tid < 256) { const int dir = F.tid >> 7, ch = F.tid & 127; float sa = 0.f, h = 0.f;
#pragma unroll
        for (int q = 0; q < 4; ++q) { const float a = sub[((dir * 4 + q) * 128 + ch) * 2]; h = __expf(a) * h + sub[((dir * 4 + q) * 128 + ch) * 2 + 1]; sa += a; }
        const size_t o = (((size_t)dir * NSEQ + seq) * NSEG + seg) * LW + k * 128 + ch;
        ((float*)(F.ws + WS_SEGA))[o] = __expf(sa); ((float*)(F.ws + WS_SEGH))[o] = h; }
}
DI void lru_carry(Frame& F) {
    const float* SA = (const float*)(F.ws + WS_SEGA); const float* SH = (const float*)(F.ws + WS_SEGH); float* SC = (float*)(F.ws + WS_SEGC);
    constexpr int NU = 2 * NSEQ * LW;
#pragma unroll 1
    for (int u = F.vcu * NTHR + F.tid; u < NU; u += F.G * NTHR) {
        const int ch = u % LW, seq = (u / LW) % NSEQ, dir = u / (LW * NSEQ);
        const size_t o0 = ((size_t)dir * NSEQ + seq) * NSEG * LW + ch; float h = 0.f;
#pragma unroll 8
        for (int jj = 0; jj < NSEG; ++jj) { const int j = dir ? NSEG - 1 - jj : jj; const size_t o = o0 + (size_t)j * LW;
            const float a = SA[o], b = SH[o]; SC[o] = h; h = a * h + b; }
    }
}
DI void lru_out_unit(Frame& F, int unit) {
    constexpr int CGW = LW < NTHR ? LW : NTHR, NCG = LW / CGW, C8 = CGW / 8;
    const int cg = unit % NCG, seg = (unit / NCG) % NSEG, seq = unit / (NCG * NSEG);
    const int t0 = seq * SEQ + seg * 64, c0 = cg * CGW;
    const bf16* PROJ = (const bf16*)(F.ws + WS_PROJ); bf16* MIX = (bf16*)(F.ws + WS_MIX);
    LAS bf16* gt = (LAS bf16*)(F.lds + RING_OFF);
    __syncthreads();
    for (int q = F.tid; q < 64 * C8; q += NTHR) { const int row = q / C8, c8 = q % C8;
        *(LAS v4u*)(gt + row * CGW + c8 * 8) = *(const v4u*)(PROJ + (size_t)(t0 + row) * OIN_P + O_G + c0 + c8 * 8); }
    __syncthreads();
    if (F.tid < CGW) {
        const int ch = c0 + F.tid;
        const float* SH = (const float*)(F.ws + WS_SEGC);
        float hf = SH[(((size_t)0 * NSEQ + seq) * NSEG + seg) * LW + ch], hb = SH[(((size_t)1 * NSEQ + seq) * NSEG + seg) * LW + ch];
        const size_t rf = ((((size_t)0 * NSEQ + seq) * NSEG + seg) * LW + ch) * 64, rb = ((((size_t)1 * NSEQ + seq) * NSEG + seg) * LW + ch) * 64;
        const bf16* LA = (const bf16*)(F.ws + WS_LA); const bf16* LB = (const bf16*)(F.ws + WS_LB);
        float hfs[64];
        { v4u la[8], lb[8];
#pragma unroll
          for (int q = 0; q < 8; ++q) { la[q] = *(const v4u*)(LA + rf + q * 8); lb[q] = *(const v4u*)(LB + rf + q * 8); }
#pragma unroll
          for (int q = 0; q < 8; ++q)
#pragma unroll
              for (int j = 0; j < 4; ++j) { hf = __expf(bflo(la[q][j])) * hf + bflo(lb[q][j]); hfs[q * 8 + 2 * j] = hf; hf = __expf(bfhi(la[q][j])) * hf + bfhi(lb[q][j]); hfs[q * 8 + 2 * j + 1] = hf; } }
        { v4u la[8], lb[8];
#pragma unroll
          for (int q = 0; q < 8; ++q) { la[q] = *(const v4u*)(LA + rb + q * 8); lb[q] = *(const v4u*)(LB + rb + q * 8); }
#pragma unroll
          for (int q = 7; q >= 0; --q)
#pragma unroll
              for (int j = 3; j >= 0; --j) {
                  { const int i = q * 8 + 2 * j + 1; hb = __expf(bfhi(la[q][j])) * hb + bfhi(lb[q][j]);
                    gt[i * CGW + F.tid] = (bf16)f2bf(gelu_tanh(bf2f(gt[i * CGW + F.tid])) * (hfs[i] + hb)); }
                  { const int i = q * 8 + 2 * j; hb = __expf(bflo(la[q][j])) * hb + bflo(lb[q][j]);
                    gt[i * CGW + F.tid] = (bf16)f2bf(gelu_tanh(bf2f(gt[i * CGW + F.tid])) * (hfs[i] + hb)); } } }
    }
    __syncthreads();
    for (int q = F.tid; q < 64 * C8; q += NTHR) { const int row = q / C8, c8 = q % C8;
        *(v4u*)(MIX + (size_t)(t0 + row) * OMIX + SIN + c0 + c8 * 8) = *(const LAS v4u*)(gt + row * CGW + c8 * 8); }
}

DI void odd_mixer_a(Frame& F, const OddW& W) { ssd_prep(F, W); }
DI void odd_mixer_b(Frame& F, const OddW& W) {
    constexpr int NS2 = NSEQ * 2 * SNH, NL1 = NSEQ * NSEG * LNB;
    for (int u = F.vcu; u < NS2; u += F.G) ssd_scan_unit(F, u);
    constexpr int L1_SKEW = 18;
    const int nheavy = NS2 > F.G ? (NS2 - F.G < F.G ? NS2 - F.G : F.G) : 0, nlight = F.G - nheavy;
    for (int s = 0;; ++s) {
        int u;
        if (s < L1_SKEW) { if (F.vcu < nheavy) continue; u = s * nlight + (F.vcu - nheavy); }
        else u = L1_SKEW * nlight + (s - L1_SKEW) * F.G + F.vcu;
        if (u >= NL1) break;
        lru_gate_unit(F, u, W);
    }
}
DI void odd_mixer_c(Frame& F, const OddW& W) { lru_carry(F); ssd_post(F, W); }
DI void odd_mixer_d(Frame& F, const OddW& W) {
    constexpr int NL2 = NSEQ * NSEG * (LW < NTHR ? 1 : LW / NTHR);
    for (int u = F.vcu; u < NL2; u += F.G) lru_out_unit(F, u);
}

constexpr size_t WS_NEED_A = WS_END_FFN > WS_END_EVEN ? WS_END_FFN : WS_END_EVEN;
constexpr size_t WS_NEED = WS_NEED_A > WS_END_ODD ? WS_NEED_A : WS_END_ODD;


struct Args { const float* in[40]; float* out; unsigned char* ws; int ph_lo, ph_hi, li, pad; };
__global__ void __launch_bounds__(NTHR, 2) fwd_kernel(Args args) {
    DECL_DYN_LDS(lds);
    Frame F;
    F.lds = (LAS unsigned char*)lds;
    F.MISC = (volatile LAS unsigned*)(F.lds + MISC_OFF);
    F.tid = threadIdx.x; F.lane = F.tid & 63; F.wave = __builtin_amdgcn_readfirstlane(F.tid >> 6);
    F.G = gridDim.x; { const int bx = blockIdx.x; F.vcu = (F.G % 8 == 0) ? (bx % 8) * (F.G / 8) + bx / 8 : bx; }
    F.out = args.out; F.ws = args.ws;
    F.ctl = (gu32*)(args.ws + WS_CTL);
    for (int u = F.tid; u < (LDS_BYTES - LDSCTL_OFF) / 4; u += NTHR) ((LAS unsigned*)(F.lds + LDSCTL_OFF))[u] = 0u;
    __syncthreads();
    const int lo = args.ph_lo, hi = args.ph_hi;
#ifndef HOST_EMU
    XcdBarrier bar; bar.bar = (unsigned*)(F.ctl + CW_BAR) + args.li * XCD_BAR_WORDS; bar.x = 0; bar.st = nullptr;
    if (hi - lo > 1) bar = xcd_barrier_post((unsigned*)(F.ctl + CW_BAR) + args.li * XCD_BAR_WORDS, F.MISC + 8);
#define GRID_BAR() xcd_barrier(bar)
#else
#define GRID_BAR() do {} while (0)
#endif
#define IN(k) (lo <= (k) && (k) < hi)
#define SEAM(k) do { if (IN(k) && IN((k) + 1)) GRID_BAR(); } while (0)
    bf16* XB = (bf16*)(F.ws + WS_XB); bf16* PROJ = (bf16*)(F.ws + WS_PROJ); bf16* MIX = (bf16*)(F.ws + WS_MIX);
    float* STATS = (float*)(F.ws + WS_STATS);
    bf16* YB = (bf16*)F.out; bf16* Y4 = (bf16*)(F.ws + WS_MIX);
    float* EDGEG = (float*)(F.ws + WS_H); bf16* ACT = (bf16*)(F.ws + WS_ACT);

    const WSrc WS{args.in[2], args.in[16], args.in[17], args.in[31], args.in[34], args.in[37]};
    if (IN(PH_PRO)) { p0_prologue(F, args.in[0], args.in[1], WS); hyena_pro(F, args.in[10], args.in[11], args.in[12], args.in[13]); lru_pro(F, args.in[26], args.in[28]); SEAM(PH_PRO); }

    if (IN(PH_EIN)) {
        pg8::Gemm g{XB, (const bf16*)(F.ws + WS_WEIN), T, EIN_P, DM}; pg8::StaticOrder S; S.init(T, EIN_P, F.G, (int)blockIdx.x);
        pg8::EpiBf16<0> E{PROJ, EIN_P, nullptr, 0, 0, 1.f};
        pg8::gemm_phase<pg8::EpiBf16<0>, pg8::StaticOrder, PG8_ALIGN, PG8_SP2>(F.lds + RING_OFF, g, S, E);
        conv_late_tail(F, WS, (T / 256) * (EIN_P / 256), (int)blockIdx.x, 0, LATE_A);
        SEAM(PH_EIN);
    }
    const EvenW EW{args.in[3], args.in[4], args.in[5], args.in[6], args.in[7], args.in[8], args.in[9], args.in[14], args.in[15]};
    if (IN(PH_EMA)) { even_mixer_a(F, EW); SEAM(PH_EMA); }
    if (IN(PH_EMB)) { even_mixer_b(F, EW); SEAM(PH_EMB); }
    if (IN(PH_EMC)) { even_mixer_c(F, EW); SEAM(PH_EMC); }
    if (IN(PH_EOUT)) {
        pg8::Gemm g{MIX, (const bf16*)(F.ws + WS_WEOUT), T, DM, EMIX}; pg8::StaticOrder S; S.init(T, DM, F.G, (int)blockIdx.x);
        pg8::EpiResBf<true> E{args.in[0], args.in[1], NSEQ_P * SEQ, YB, DM, DN_ALPHA, nullptr, nullptr, nullptr};
        pg8::gemm_phase<pg8::EpiResBf<true>, pg8::StaticOrder, PG8_ALIGN, PG8_SP2>(F.lds + RING_OFF, g, S, E);
        SEAM(PH_EOUT);
    }
    if (IN(PH_LN1A)) { ln_phase<false>(F, YB, nullptr, XB, STATS, args.in[32], args.in[33]); SEAM(PH_LN1A); }
    if (IN(PH_UP0)) {
        pg8::Gemm g{XB, (const bf16*)(F.ws + WS_WUP), T, FF2, DM}; pg8::StaticOrder S; S.init(T, FF2, F.G, (int)blockIdx.x);
        pg8::EpiConvGate E{ACT, FF, args.in[35], args.in[36], EDGEG, (LAS float*)(F.lds + EDGE_OFF)};
        pg8::gemm_phase<pg8::EpiConvGate, pg8::StaticOrder, PG8_ALIGN, PG8_SP2>(F.lds + RING_OFF, g, S, E);
        conv_late_tail(F, WS, (T / 256) * (FF2 / 256), (int)blockIdx.x, LATE_A, LATE_A + LATE_B);
        SEAM(PH_UP0);
    }
    if (IN(PH_CG0)) { convgate_fix_phase(F, EDGEG, ACT, args.in[35], args.in[36]); SEAM(PH_CG0); }
    if (IN(PH_DN0)) {
        pg8::Gemm g{ACT, (const bf16*)(F.ws + WS_WDN), T, DM, FF}; pg8::StaticOrder S; S.init(T, DM, F.G, (int)blockIdx.x);
        pg8::EpiResBf<false> E{YB, nullptr, 0, YB, DM, DN_ALPHA, STATS, args.in[32], args.in[33]};
        pg8::gemm_phase<pg8::EpiResBf<false>, pg8::StaticOrder, PG8_ALIGN, PG8_SP2>(F.lds + RING_OFF, g, S, E);
        SEAM(PH_DN0);
    }
    if (IN(PH_LN2A)) { ln_phase<false>(F, YB, nullptr, XB, STATS, args.in[38], args.in[39]); SEAM(PH_LN2A); }

    if (IN(PH_OIN)) {
        pg8::Gemm g{XB, (const bf16*)(F.ws + WS_WOIN), T, OIN_P, DM}; pg8::StaticOrder S; S.init(T, OIN_P, F.G, (int)blockIdx.x);
        pg8::EpiBf16<0> E{PROJ, OIN_P, nullptr, 0, 0, 1.f};
        pg8::gemm_phase<pg8::EpiBf16<0>, pg8::StaticOrder, PG8_ALIGN, PG8_SP2>(F.lds + RING_OFF, g, S, E);
        SEAM(PH_OIN);
    }
    const OddW OW{args.in[18], args.in[19], args.in[20], args.in[21], args.in[22], args.in[23], args.in[24], args.in[25], args.in[26], args.in[27], args.in[28], args.in[29], args.in[30]};
    if (IN(PH_OMA)) { odd_mixer_a(F, OW); SEAM(PH_OMA); }
    if (IN(PH_OMB)) { odd_mixer_b(F, OW); SEAM(PH_OMB); }
    if (IN(PH_OMC)) { odd_mixer_c(F, OW); SEAM(PH_OMC); }
    if (IN(PH_OMD)) { odd_mixer_d(F, OW); SEAM(PH_OMD); }
    if (IN(PH_OOUT)) {
        pg8::Gemm g{MIX, (const bf16*)(F.ws + WS_WOOUT), T, DM, OMIX}; pg8::StaticOrder S; S.init(T, DM, F.G, (int)blockIdx.x);
        pg8::EpiResBf<false> E{YB, nullptr, 0, YB, DM, DN_ALPHA, STATS, args.in[38], args.in[39]};
        pg8::gemm_phase<pg8::EpiResBf<false>, pg8::StaticOrder, PG8_ALIGN, PG8_SP2>(F.lds + RING_OFF, g, S, E);
        SEAM(PH_OOUT);
    }
    if (IN(PH_LN1B)) { ln_phase<false>(F, YB, nullptr, XB, STATS, args.in[32] + DM, args.in[33] + DM); SEAM(PH_LN1B); }
    if (IN(PH_UP1)) {
        pg8::Gemm g{XB, (const bf16*)(F.ws + WS_WUP + SZ_WUP1), T, FF2, DM}; pg8::StaticOrder S; S.init(T, FF2, F.G, (int)blockIdx.x);
        pg8::EpiConvGate E{ACT, FF, args.in[35] + (size_t)3 * FF2, args.in[36] + FF2, EDGEG, (LAS float*)(F.lds + EDGE_OFF)};
        pg8::gemm_phase<pg8::EpiConvGate, pg8::StaticOrder, PG8_ALIGN, PG8_SP2>(F.lds + RING_OFF, g, S, E);
        SEAM(PH_UP1);
    }
    if (IN(PH_CG1)) { convgate_fix_phase(F, EDGEG, ACT, args.in[35] + (size_t)3 * FF2, args.in[36] + FF2); SEAM(PH_CG1); }
    if (IN(PH_DN1)) {
        pg8::Gemm g{ACT, (const bf16*)(F.ws + WS_WDN + SZ_WDN1), T, DM, FF}; pg8::StaticOrder S; S.init(T, DM, F.G, (int)blockIdx.x);
        pg8::EpiResBf<false> E{YB, nullptr, 0, Y4, DM, DN_ALPHA, STATS, args.in[32] + DM, args.in[33] + DM};
        pg8::gemm_phase<pg8::EpiResBf<false>, pg8::StaticOrder, PG8_ALIGN, PG8_SP2>(F.lds + RING_OFF, g, S, E);
        SEAM(PH_DN1);
    }
    if (IN(PH_LN2B)) { ln_phase<true>(F, Y4, F.out, nullptr, STATS, args.in[38] + DM, args.in[39] + DM); }
#undef IN
#undef SEAM
}

#ifndef HOST_EMU
extern "C" void kernel_launch(void* const* d_in, const int* in_sizes, int n_in, void* d_out, int out_size, void* d_ws, size_t ws_size, hipStream_t stream) {
    static int grid = 0;
    if (grid == 0) {
        if (n_in != 40 || out_size != T * DM || ws_size < WS_NEED) { fprintf(stderr, "kernel_launch: shape mismatch n_in %d out %d ws %zu (need %zu)\n", n_in, out_size, ws_size, (size_t)WS_NEED); grid = -1; return; }
        int dev = 0, cus = 0, per_cu = 0;
        if (hipGetDevice(&dev) != hipSuccess || hipDeviceGetAttribute(&cus, hipDeviceAttributeMultiprocessorCount, dev) != hipSuccess) { grid = -1; return; }
        if (hipFuncSetAttribute((const void*)fwd_kernel, hipFuncAttributeMaxDynamicSharedMemorySize, LDS_BYTES) != hipSuccess) { fprintf(stderr, "kernel_launch: hipFuncSetAttribute failed\n"); grid = -1; return; }
        if (hipOccupancyMaxActiveBlocksPerMultiprocessor(&per_cu, (const void*)fwd_kernel, NTHR, LDS_BYTES) != hipSuccess || per_cu < 1) fprintf(stderr, "kernel_launch: occupancy query says %d\n", per_cu);
        (void)hipGetLastError();
        grid = cus;
    }
    if (grid < 0) return;
    if (hipMemsetAsync((char*)d_ws + WS_CTL, 0, CTL_ZERO_BYTES, stream) != hipSuccess) return;
    Args a{};
    for (int i = 0; i < 40; ++i) a.in[i] = (const float*)d_in[i];
    a.out = (float*)d_out; a.ws = (unsigned char*)d_ws;
#if defined(PROBE_RERUN_LO)
    a.ph_lo = 0; a.ph_hi = PROBE_RERUN_HI + 1; a.li = 0;
    hipLaunchKernelGGL(fwd_kernel, dim3(grid), dim3(NTHR), LDS_BYTES, stream, a);
    a.ph_lo = PROBE_RERUN_LO; a.ph_hi = NPH; a.li = 1;
    hipLaunchKernelGGL(fwd_kernel, dim3(grid), dim3(NTHR), LDS_BYTES, stream, a);
#elif MK_ONE_LAUNCH
    a.ph_lo = 0; a.ph_hi = NPH;
    hipLaunchKernelGGL(fwd_kernel, dim3(grid), dim3(NTHR), LDS_BYTES, stream, a);
#else
    for (int p = 0; p < NPH; ++p) { a.ph_lo = p; a.ph_hi = p + 1; hipLaunchKernelGGL(fwd_kernel, dim3(grid), dim3(NTHR), LDS_BYTES, stream, a); }
#endif
}
#endif
```
